# Optimizing an MI355X kernel written in HIP

```python
import math
import jax
import jax.numpy as jnp
from jax import lax
import numpy as np

D_MODEL = 1024
BATCH = 32
SEQ = 2048
DEPTH = 2

GRID_W = 64
CTX_LEN = 256
EPS = 1e-6
N_MOD = 6

CONV_W = 512
CONV_K = 3

RG_W = 512
RG_BLOCKS = 8
RG_BLOCK_W = RG_W // RG_BLOCKS
RG_CONV_K = 4
RG_C = 8.0

DA_HEADS = 4
DA_HEAD_DIM = 64
DA_V_DIM = 2 * DA_HEAD_DIM
DA_QK_W = DA_HEADS * 2 * DA_HEAD_DIM
DA_W = DA_HEADS * DA_V_DIM
Q_BLOCK = 128
ROPE_AXIS_DIM = DA_HEAD_DIM // 2
ROPE_BASE = 10000.0

N_BRANCH = 3
SPLIT_SIZES = (CONV_W, CONV_W, CONV_W, RG_W, RG_W, DA_QK_W, DA_QK_W, DA_W, D_MODEL, D_MODEL, D_MODEL)
D_IN = 3 * CONV_W + 2 * RG_W + 2 * DA_QK_W + DA_W + N_BRANCH * D_MODEL

FF_DENSE = 3584
N_EXPERTS = 8
TOP_K = 2
FF_EXPERT = 3584
MOE_BLOCK = 512
N_DENSE = (DEPTH + 1) // 2
N_MOE = DEPTH // 2

kernel_name = 'hybrid_flow_block'


def rmsnorm(x, w):
    xf = x.astype(jnp.float32)
    y = xf * lax.rsqrt(jnp.mean(xf * xf, axis=-1, keepdims=True) + EPS)
    return (y * w.astype(jnp.float32)).astype(x.dtype)


def modulate(h, shift, scale):
    return h * (1.0 + scale) + shift


def split_columns(z):
    out, start = [], 0
    for size in SPLIT_SIZES:
        out.append(z[..., start:start + size])
        start += size
    return out


def dwconv(x, w, pad_left, pad_right):
    n = x.shape[1]
    xp = jnp.pad(x, ((0, 0), (pad_left, pad_right), (0, 0)))
    return sum(xp[:, k:k + n] * w[k] for k in range(w.shape[0]))


def short_conv_mixer(gate_b, gate_c, xin, w):
    return gate_b * dwconv(gate_c * xin, w, CONV_K // 2, CONV_K // 2)


def _linrec_combine(e1, e2):
    a1, b1 = e1
    a2, b2 = e2
    return a1 * a2, a2 * b1 + b2


def rglru_direction(xr, h0, conv_w, conv_b, wa, ba, wx, bx, lam, reverse):
    pad = (0, RG_CONV_K - 1) if reverse else (RG_CONV_K - 1, 0)
    xc = dwconv(xr, conv_w, pad[0], pad[1]) + conv_b
    bsz, n, _ = xc.shape
    xg = xc.reshape(bsz, n, RG_BLOCKS, RG_BLOCK_W)
    r = jax.nn.sigmoid(jnp.einsum('bngi,gij->bngj', xg, wa) + ba).reshape(bsz, n, RG_W)
    i = jax.nn.sigmoid(jnp.einsum('bngi,gij->bngj', xg, wx) + bx).reshape(bsz, n, RG_W)
    log_a = (-RG_C * r.astype(jnp.float32)) * jax.nn.softplus(-lam.astype(jnp.float32))
    a = jnp.exp(log_a)
    b = jnp.sqrt(-jnp.expm1(2.0 * log_a)) * (i * xc).astype(jnp.float32)
    if h0 is not None:
        t0 = n - 1 if reverse else 0
        b = b.at[:, t0].add(a[:, t0] * h0)
    _, h = lax.associative_scan(_linrec_combine, (a, b), reverse=reverse, axis=1)
    return h


def axial_rope_tables(n, dtype):
    rows = n // GRID_W
    pos_r = jnp.repeat(jnp.arange(rows, dtype=jnp.float32), GRID_W)
    pos_c = jnp.broadcast_to(jnp.arange(GRID_W, dtype=jnp.float32), (rows, GRID_W)).reshape(-1)
    inv_freq = ROPE_BASE ** (-jnp.arange(0, ROPE_AXIS_DIM, 2, dtype=jnp.float32) / ROPE_AXIS_DIM)
    ang = jnp.stack([pos_r[:, None] * inv_freq, pos_c[:, None] * inv_freq], axis=1)
    return jnp.cos(ang).astype(dtype), jnp.sin(ang).astype(dtype)


def apply_axial_rope(x, cos, sin):
    shp = x.shape
    xa = x.reshape(shp[:-1] + (2, 2, ROPE_AXIS_DIM // 2))
    x1, x2 = xa[..., 0, :], xa[..., 1, :]
    cb = cos[None, :, None, None]
    sb = sin[None, :, None, None]
    out = jnp.stack([x1 * cb - x2 * sb, x2 * cb + x1 * sb], axis=-2)
    return out.reshape(shp)


def diff_lambda(da_lambda, lam_init):
    lf = da_lambda.astype(jnp.float32)
    return jnp.exp(jnp.sum(lf[0] * lf[1])) - jnp.exp(jnp.sum(lf[2] * lf[3])) + lam_init


def diff_softmax_mix(q1, q2, k1, k2, v, lam):
    scale = DA_HEAD_DIM ** -0.5
    p1 = jax.nn.softmax(jnp.einsum('bqhd,bkhd->bhqk', q1, k1).astype(jnp.float32) * scale, axis=-1)
    p2 = jax.nn.softmax(jnp.einsum('bqhd,bkhd->bhqk', q2, k2).astype(jnp.float32) * scale, axis=-1)
    p = (p1 - lam * p2).astype(v.dtype)
    return jnp.einsum('bhqk,bkhe->bqhe', p, v)


def latent_diff_attention(q, k, v, ck, cv, lam):
    bsz, n = q.shape[:2]
    kk = jnp.concatenate([k, ck], axis=1)
    vv = jnp.concatenate([v, cv], axis=1)
    k1, k2 = kk[..., 0, :], kk[..., 1, :]
    nb = n // Q_BLOCK
    qb = q.reshape(bsz, nb, Q_BLOCK, DA_HEADS, 2, DA_HEAD_DIM).swapaxes(0, 1)
    o = lax.map(lambda qblk: diff_softmax_mix(qblk[..., 0, :], qblk[..., 1, :], k1, k2, vv, lam), qb)
    return o.swapaxes(0, 1).reshape(bsz, n, DA_HEADS, DA_V_DIM)


def diff_attn_out(o, subln_w, lam_init):
    o = rmsnorm(o, subln_w) * (1.0 - lam_init)
    return o.reshape(o.shape[:2] + (DA_W,))


def gated_merge(y_a, y_r, y_d, g_a, g_r, g_d, w_branch, w_out):
    m = (jax.nn.sigmoid(g_a) * (y_a @ w_branch[0])
         + jax.nn.sigmoid(g_r) * (y_r @ w_branch[1])
         + jax.nn.sigmoid(g_d) * (y_d @ w_branch[2]))
    return m @ w_out


def hybrid_mixer(u, uc, cos, sin, w_in, conv_a_w, rg_conv_w, rg_conv_b, rg_wa, rg_ba, rg_wx, rg_bx,
                 rg_lambda, da_lambda, da_subln_w, w_branch, w_out, lam_init, need_ctx):
    bsz, n, _ = u.shape
    n_ctx = uc.shape[1]
    a_b, a_c, a_x, r_g, r_x, q, k, v, g_a, g_r, g_d = split_columns(u @ w_in)
    ca_b, ca_c, ca_x, cr_g, cr_x, cq, ck, cv, cg_a, cg_r, cg_d = split_columns(uc @ w_in)

    fwd = (rg_conv_w[0], rg_conv_b[0], rg_wa[0], rg_ba[0], rg_wx[0], rg_bx[0], rg_lambda[0])
    bwd = (rg_conv_w[1], rg_conv_b[1], rg_wa[1], rg_ba[1], rg_wx[1], rg_bx[1], rg_lambda[1])
    hf_ctx = rglru_direction(cr_x, None, *fwd, reverse=False)
    hb_ctx = rglru_direction(cr_x, None, *bwd, reverse=True)
    hf = rglru_direction(r_x, hf_ctx[:, -1], *fwd, reverse=False)
    hb = rglru_direction(r_x, hb_ctx[:, 0], *bwd, reverse=True)
    y_r = jax.nn.gelu(r_g) * (hf + hb).astype(r_g.dtype)

    lam = diff_lambda(da_lambda, lam_init)
    q = apply_axial_rope(q.reshape(bsz, n, DA_HEADS, 2, DA_HEAD_DIM), cos, sin)
    k = apply_axial_rope(k.reshape(bsz, n, DA_HEADS, 2, DA_HEAD_DIM), cos, sin)
    v = v.reshape(bsz, n, DA_HEADS, DA_V_DIM)
    ck = ck.reshape(bsz, n_ctx, DA_HEADS, 2, DA_HEAD_DIM)
    cv = cv.reshape(bsz, n_ctx, DA_HEADS, DA_V_DIM)
    y_d = diff_attn_out(latent_diff_attention(q, k, v, ck, cv, lam), da_subln_w, lam_init)

    y_a = short_conv_mixer(a_b, a_c, a_x, conv_a_w)
    y = gated_merge(y_a, y_r, y_d, g_a, g_r, g_d, w_branch, w_out)
    if not need_ctx:
        return y, None

    yc_a = short_conv_mixer(ca_b, ca_c, ca_x, conv_a_w)
    yc_r = jax.nn.gelu(cr_g) * (hf_ctx + hb_ctx).astype(cr_g.dtype)
    cq = cq.reshape(bsz, n_ctx, DA_HEADS, 2, DA_HEAD_DIM)
    oc = diff_softmax_mix(cq[..., 0, :], cq[..., 1, :], ck[..., 0, :], ck[..., 1, :], cv, lam)
    yc_d = diff_attn_out(oc, da_subln_w, lam_init)
    yc = gated_merge(yc_a, yc_r, yc_d, cg_a, cg_r, cg_d, w_branch, w_out)
    return y, yc


def swiglu(h, w13, w2):
    g, u = jnp.split(h @ w13, 2, axis=-1)
    return (jax.nn.silu(g) * u) @ w2


def moe_swiglu(h, router_w, w13, w2):
    shp = h.shape
    t = h.reshape(-1, D_MODEL)
    n_tok = t.shape[0]
    logits = (t @ router_w).astype(jnp.float32)
    top_v, top_e = lax.top_k(logits, TOP_K)
    gates = jax.nn.softmax(top_v, axis=-1)
    flat_e = top_e.reshape(-1)
    flat_tok = jnp.repeat(jnp.arange(n_tok, dtype=jnp.int32), TOP_K)
    flat_g = gates.reshape(-1)
    order = jnp.argsort(flat_e)
    se, stok, sg = flat_e[order], flat_tok[order], flat_g[order]
    counts = jnp.bincount(flat_e, length=N_EXPERTS)
    padded = (counts + MOE_BLOCK - 1) // MOE_BLOCK * MOE_BLOCK
    pad_end = jnp.cumsum(padded)
    pad_start = pad_end - padded
    start = jnp.cumsum(counts) - counts
    n_slots = n_tok * TOP_K
    dest = pad_start[se] + jnp.arange(n_slots, dtype=pad_start.dtype) - start[se]
    n_blocks = -(-n_slots // MOE_BLOCK) + N_EXPERTS
    buf_tok = jnp.full((n_blocks * MOE_BLOCK,), n_tok, dtype=jnp.int32).at[dest].set(stok)
    block_e = jnp.minimum(jnp.searchsorted(pad_end, jnp.arange(n_blocks) * MOE_BLOCK, side='right'),
                          N_EXPERTS - 1)
    t_pad = jnp.concatenate([t, jnp.zeros((1, D_MODEL), t.dtype)], axis=0)
    xb = t_pad[buf_tok].reshape(n_blocks, MOE_BLOCK, D_MODEL)
    yb = lax.map(lambda a: swiglu(a[0], w13[a[1]], w2[a[1]]), (xb, block_e))
    ys = yb.reshape(-1, D_MODEL)[dest]
    out = jnp.zeros_like(t).at[stok].add(sg[:, None].astype(t.dtype) * ys)
    return out.reshape(shp)


def setup_inputs(seed: int = 0) -> dict:
    key = jax.random.key(seed)
    keys = jax.random.split(key, 32)
    f32 = jnp.float32

    def normal(i, shape, scale=1.0):
        return jax.random.normal(keys[i], shape, f32) * scale

    u = jax.random.uniform(keys[20], (DEPTH, 2, RG_W), f32, 0.9, 0.999)
    a0 = u ** (1.0 / RG_C)
    return {
        'x': normal(0, (BATCH, SEQ, D_MODEL)),
        'c': normal(1, (BATCH, D_MODEL)),
        'ctx': normal(2, (BATCH, CTX_LEN, D_MODEL)),
        'c_ctx': normal(3, (D_MODEL,)),
        'mod_w': normal(4, (DEPTH, D_MODEL, N_MOD * D_MODEL), D_MODEL ** -0.5),
        'mod_b': normal(5, (DEPTH, N_MOD * D_MODEL), 0.02),
        'norm1_w': 1.0 + normal(6, (DEPTH, D_MODEL), 0.02),
        'norm2_w': 1.0 + normal(7, (DEPTH, D_MODEL), 0.02),
        'w_in': normal(8, (DEPTH, D_MODEL, D_IN), D_MODEL ** -0.5),
        'conv_a_w': normal(9, (DEPTH, CONV_K, CONV_W), CONV_K ** -0.5),
        'rg_conv_w': normal(10, (DEPTH, 2, RG_CONV_K, RG_W), RG_CONV_K ** -0.5),
        'rg_conv_b': normal(11, (DEPTH, 2, RG_W), 0.02),
        'rg_wa': normal(12, (DEPTH, 2, RG_BLOCKS, RG_BLOCK_W, RG_BLOCK_W), RG_BLOCK_W ** -0.5),
        'rg_ba': normal(13, (DEPTH, 2, RG_BLOCKS, RG_BLOCK_W), 0.02),
        'rg_wx': normal(14, (DEPTH, 2, RG_BLOCKS, RG_BLOCK_W, RG_BLOCK_W), RG_BLOCK_W ** -0.5),
        'rg_bx': normal(15, (DEPTH, 2, RG_BLOCKS, RG_BLOCK_W), 0.02),
        'rg_lambda': jnp.log(a0) - jnp.log1p(-a0),
        'da_lambda': normal(16, (DEPTH, 4, DA_HEAD_DIM), 0.1),
        'da_subln_w': 1.0 + normal(17, (DEPTH, DA_V_DIM), 0.02),
        'w_branch': normal(18, (DEPTH, N_BRANCH, CONV_W, D_MODEL), CONV_W ** -0.5),
        'w_out': normal(19, (DEPTH, D_MODEL, D_MODEL), D_MODEL ** -0.5),
        'ffn_w13': normal(21, (N_DENSE, D_MODEL, 2 * FF_DENSE), D_MODEL ** -0.5),
        'ffn_w2': normal(22, (N_DENSE, FF_DENSE, D_MODEL), FF_DENSE ** -0.5),
        'router_w': normal(23, (N_MOE, D_MODEL, N_EXPERTS), D_MODEL ** -0.5),
        'moe_w13': normal(24, (N_MOE, N_EXPERTS, D_MODEL, 2 * FF_EXPERT), D_MODEL ** -0.5),
        'moe_w2': normal(25, (N_MOE, N_EXPERTS, FF_EXPERT, D_MODEL), FF_EXPERT ** -0.5),
        'final_norm_w': 1.0 + normal(26, (D_MODEL,), 0.02),
    }


def reference(x, c, ctx, c_ctx, mod_w, mod_b, norm1_w, norm2_w, w_in, conv_a_w, rg_conv_w, rg_conv_b,
              rg_wa, rg_ba, rg_wx, rg_bx, rg_lambda, da_lambda, da_subln_w, w_branch, w_out,
              ffn_w13, ffn_w2, router_w, moe_w13, moe_w2, final_norm_w):
    n = x.shape[1]
    cos, sin = axial_rope_tables(n, x.dtype)
    cx = ctx
    for l in range(DEPTH):
        last = l == DEPTH - 1
        lam_init = 0.8 - 0.6 * math.exp(-0.3 * l)
        mod = jax.nn.silu(c) @ mod_w[l] + mod_b[l]
        mod_c = jax.nn.silu(c_ctx) @ mod_w[l] + mod_b[l]
        sh1, sc1, g1, sh2, sc2, g2 = jnp.split(mod[:, None, :], N_MOD, axis=-1)
        csh1, csc1, cg1, csh2, csc2, cg2 = jnp.split(mod_c, N_MOD)

        u = modulate(rmsnorm(x, norm1_w[l]), sh1, sc1)
        uc = modulate(rmsnorm(cx, norm1_w[l]), csh1, csc1)
        y, yc = hybrid_mixer(u, uc, cos, sin, w_in[l], conv_a_w[l], rg_conv_w[l], rg_conv_b[l],
                             rg_wa[l], rg_ba[l], rg_wx[l], rg_bx[l], rg_lambda[l], da_lambda[l],
                             da_subln_w[l], w_branch[l], w_out[l], lam_init, not last)
        x = x + g1 * y
        if not last:
            cx = cx + cg1 * yc

        j = l // 2
        h = modulate(rmsnorm(x, norm2_w[l]), sh2, sc2)
        if l % 2 == 0:
            x = x + g2 * swiglu(h, ffn_w13[j], ffn_w2[j])
        else:
            x = x + g2 * moe_swiglu(h, router_w[j], moe_w13[j], moe_w2[j])
        if not last:
            hc = modulate(rmsnorm(cx, norm2_w[l]), csh2, csc2)
            if l % 2 == 0:
                cx = cx + cg2 * swiglu(hc, ffn_w13[j], ffn_w2[j])
            else:
                cx = cx + cg2 * moe_swiglu(hc, router_w[j], moe_w13[j], moe_w2[j])
    return rmsnorm(x, final_norm_w)
```

```cpp
#include <hip/hip_runtime.h>
#include <cstdio>
#include <cstdint>

#define LAS __attribute__((address_space(3)))
typedef unsigned short bf16_t;
typedef short bf16x8 __attribute__((ext_vector_type(8)));
typedef short s16x4 __attribute__((ext_vector_type(4)));
typedef float f32x4 __attribute__((ext_vector_type(4)));
typedef float f32x2 __attribute__((ext_vector_type(2)));
typedef float f32x16 __attribute__((ext_vector_type(16)));
typedef unsigned u32x4 __attribute__((ext_vector_type(4)));
typedef unsigned u32x2 __attribute__((ext_vector_type(2)));

constexpr int D = 1024, NB = 32, SEQ = 2048, CTXL = 256, TOK = SEQ + CTXL, DIN = 7168, FF = 3584, NEXP = 8;
constexpr int ZLD = 4096 + 64;
constexpr int CH = 8, NCH = NB / CH, CROWS = CH * TOK, CTILES = CROWS / 256;
constexpr int ZC_AB = 0, ZC_AC = 512, ZC_AX = 1024, ZC_RG = 1536, ZC_RX = 2048, ZC_Q = 2560, ZC_K = 3072, ZC_V = 3584, ZC_GA = 4096;
constexpr int MTOK = CH * SEQ;
constexpr int MSLOT_MAX = 2 * MTOK + NEXP * 256;
constexpr float EPS = 1e-6f;
constexpr int NTHREADS = 512;
constexpr int LDS_BYTES = 147456, MISC_OFF = 147200;

constexpr bool DENSE_F8 = true;
constexpr int REP_SITE = -1, REP_N = 1, BAR_N = 1;
constexpr size_t al256(size_t x) { return (x + 255) & ~(size_t)255; }
constexpr size_t WS_CTL = 0;
constexpr size_t CTL_BYTES = 65536 + (REP_SITE >= 0 ? 1048576 : 0);
constexpr size_t CTL_ZEROG = 65536;
constexpr size_t CTL_CNT = 16384;
constexpr size_t WS_MOD = WS_CTL + CTL_BYTES;
constexpr size_t WS_ROPE = WS_MOD + al256((size_t)2 * 33 * 6144 * 4);
constexpr size_t WS_GB = WS_ROPE + (size_t)2 * 2048 * 32 * 4;
constexpr size_t WS_COEF = WS_GB + (size_t)2 * 2048 * 4;
constexpr size_t WS_LAM = WS_COEF + (size_t)2 * 1024 * 4;
constexpr size_t WS_WIN = WS_LAM + 256;
constexpr size_t WS_WBR = WS_WIN + (size_t)2 * DIN * D * 2;
constexpr size_t WS_WOUT = WS_WBR + (size_t)2 * D * 1536 * 2;
constexpr size_t WS_WG = WS_WOUT + (size_t)2 * D * D * 2;
constexpr size_t WS_F13 = WS_WG + (size_t)2 * 8 * 256 * 256 * 2;
constexpr size_t WS_F2 = WS_F13 + (size_t)DIN * D * 2;
constexpr size_t WS_M13 = WS_F2 + (size_t)D * FF * 2;
constexpr size_t WS_M2 = WS_M13 + (size_t)NEXP * DIN * D * 2;
constexpr size_t WS_CX = WS_M2 + (size_t)NEXP * D * FF * 2;
constexpr size_t WS_U = WS_CX + (size_t)NB * CTXL * D * 4;
constexpr size_t WS_Z = WS_U + (size_t)CROWS * D * 2;
constexpr size_t WS_GZT = WS_Z + (size_t)CROWS * ZLD * 2;
constexpr size_t WS_XC = WS_GZT + (size_t)CTILES * 12 * 131072;
constexpr size_t WS_G = WS_XC + (size_t)CROWS * 1024 * 2;
constexpr size_t WS_HF = WS_G + (size_t)CROWS * 2048 * 2;
constexpr size_t WS_YCAT = WS_HF + (size_t)CROWS * 512 * 4;
constexpr size_t WS_M = WS_YCAT + (size_t)CROWS * 1536 * 2;
constexpr size_t WS_OSCR = WS_M + (size_t)CROWS * D * 2;
constexpr size_t WS_TOKE = WS_OSCR + (size_t)256 * 131072;
constexpr size_t WS_TOKP = WS_TOKE + (size_t)MTOK * 2 * 4;
constexpr size_t WS_TOKS = WS_TOKP + (size_t)MTOK * 2 * 4;
constexpr size_t WS_TSLOT = WS_TOKS + (size_t)MTOK * 2 * 4;
constexpr size_t WS_YCATC = WS_TSLOT + (size_t)MTOK * 2 * 4;
constexpr size_t WS_ZGC = WS_YCATC + (size_t)NB * CTXL * 1536 * 2;
constexpr size_t WS_XB = WS_ZGC + (size_t)NB * CTXL * 3072 * 2;
constexpr size_t WS_END = WS_XB + (size_t)NB * SEQ * D * 2;
constexpr size_t WS_ACT = WS_Z;
constexpr size_t WS_YS = WS_XC;
constexpr size_t WS_HS = WS_YCAT;
static_assert((size_t)MSLOT_MAX * FF * 2 <= WS_XC - WS_Z, "ACT fits Z + GZT");
static_assert((size_t)MSLOT_MAX * D * 4 <= WS_YCAT - WS_XC, "YS fits R1");
static_assert((size_t)MSLOT_MAX * D * 2 <= WS_OSCR - WS_YCAT, "HS fits R2");

__device__ __forceinline__ float bf2f(bf16_t b) { return __uint_as_float(((unsigned)b) << 16); }
__device__ __forceinline__ unsigned cvt_pk_bf16(float lo, float hi) { unsigned r; asm volatile("v_cvt_pk_bf16_f32 %0, %1, %2" : "=v"(r) : "v"(lo), "v"(hi)); return r; }
__device__ __forceinline__ bf16_t f2bf(float f) { return (bf16_t)(cvt_pk_bf16(f, 0.f) & 0xffffu); }
__device__ __forceinline__ void unpack8(const u32x4 w, float (&f)[8]) {
#pragma unroll
    for (int i = 0; i < 4; ++i) { f[2 * i] = __uint_as_float(w[i] << 16); f[2 * i + 1] = __uint_as_float(w[i] & 0xffff0000u); }
}
__device__ __forceinline__ u32x4 pack8(const float (&f)[8]) {
    u32x4 w; w.x = cvt_pk_bf16(f[0], f[1]); w.y = cvt_pk_bf16(f[2], f[3]); w.z = cvt_pk_bf16(f[4], f[5]); w.w = cvt_pk_bf16(f[6], f[7]); return w;
}
__device__ __forceinline__ int otid() { int t = threadIdx.x; asm volatile("" : "+v"(t)); return t; }
__device__ __forceinline__ float clamp448(float x) { return __builtin_amdgcn_fmed3f(x, -448.0f, 448.0f); }
__device__ __forceinline__ unsigned pack4_fp8(float a, float b, float c, float d) {
    int p = __builtin_amdgcn_cvt_pk_fp8_f32(clamp448(a), clamp448(b), 0, false); p = __builtin_amdgcn_cvt_pk_fp8_f32(clamp448(c), clamp448(d), p, true); return (unsigned)p; }
__device__ __forceinline__ float frcp(float x) { return __builtin_amdgcn_rcpf(x); }
__device__ __forceinline__ float sigmoidf_(float x) { return frcp(1.0f + __expf(-x)); }
__device__ __forceinline__ float wave_sum(float v) {
#pragma unroll
    for (int o = 32; o >= 1; o >>= 1) v += __shfl_xor(v, o);
    return v;
}

#define XB_TMO      128
#define XB_XCNT(j)  (256  + 64 * (j))
#define XB_XSUB(j)  (1280 + 64 * (j))
#define XB_XGEN(j)  (2304 + 64 * (j))
#define XB_TOP      3328
#define XB_TOPGEN   3392
#define XCD_BAR_WORDS 3456
#define XB_SPIN_CAP (1u << 22)

__device__ __forceinline__ unsigned xb_ld(unsigned* p)              { return __hip_atomic_load(p, __ATOMIC_RELAXED, __HIP_MEMORY_SCOPE_AGENT); }
__device__ __forceinline__ unsigned xb_add(unsigned* p, unsigned v) { return __hip_atomic_fetch_add(p, v, __ATOMIC_RELAXED, __HIP_MEMORY_SCOPE_AGENT); }
__device__ __forceinline__ unsigned xb_xcc_id() { return (unsigned)__builtin_amdgcn_s_getreg((3 << 11) | 20) & 0xFu; }
#define XB_SPIN(cond, bar) do { unsigned _sp = 0; while (cond) { __builtin_amdgcn_s_sleep(1); \
    if ((++_sp & 255u) == 0u) { if (xb_ld(&(bar)[XB_TMO])) break; if (_sp > XB_SPIN_CAP) { atomicAdd(&(bar)[XB_TMO], 1u); break; } } } } while (0)

struct XcdBarrier { unsigned* bar; unsigned x; volatile LAS unsigned* st; };

__device__ __forceinline__ XcdBarrier xcd_barrier_post(unsigned* bar, volatile LAS unsigned* st) {
    XcdBarrier b; b.bar = bar; b.x = xb_xcc_id(); b.st = st;
    if (threadIdx.x == 0) (void)xb_add(&bar[XB_XCNT(b.x)], 1u);
    return b;
}
__device__ __forceinline__ void xcd_barrier_complete(unsigned* bar, unsigned x, unsigned& nloc, unsigned& nx) {
    const unsigned G = gridDim.x * gridDim.y * gridDim.z;
    unsigned sum, cnt, mine, sp = 0u;
    for (;;) {
        sum = 0u; cnt = 0u; mine = 0u;
#pragma unroll
        for (unsigned j = 0; j < 16; ++j) { const unsigned c = xb_ld(&bar[XB_XCNT(j)]); sum += c; cnt += (c > 0u) ? 1u : 0u; mine = (j == x) ? c : mine; }
        if (sum == G) break;
        __builtin_amdgcn_s_sleep(1);
        if ((++sp & 255u) == 0u) { if (xb_ld(&bar[XB_TMO])) break; if (sp > XB_SPIN_CAP) { atomicAdd(&bar[XB_TMO], 1u); break; } }
    }
    nloc = mine > 0u ? mine : 1u; nx = cnt > 0u ? cnt : 1u;
}
__device__ __forceinline__ void xcd_barrier(const XcdBarrier& b) {
    asm volatile("s_waitcnt vmcnt(0)" ::: "memory");
    __syncthreads();
    if (threadIdx.x == 0) {
        unsigned* bar = b.bar;
        __builtin_amdgcn_s_waitcnt(0);
        unsigned nloc = b.st[0], nx = b.st[1];
        if (nloc == 0u) { xcd_barrier_complete(bar, b.x, nloc, nx); b.st[0] = nloc; b.st[1] = nx; }
        const unsigned old = xb_add(&bar[XB_XSUB(b.x)], 1u);
        const unsigned gen = old / nloc;
        if (old + 1u == (gen + 1u) * nloc) {
            __builtin_amdgcn_fence(__ATOMIC_RELEASE, "agent");
            asm volatile("s_waitcnt vmcnt(0)" ::: "memory");
            const unsigned og = xb_add(&bar[XB_TOP], 1u);
            const unsigned tg = og / nx;
            if (og + 1u == (tg + 1u) * nx) xb_add(&bar[XB_TOPGEN], 1u);
            else XB_SPIN(xb_ld(&bar[XB_TOPGEN]) == tg, bar);
            __builtin_amdgcn_fence(__ATOMIC_ACQUIRE, "agent");
            xb_add(&bar[XB_XGEN(b.x)], 1u);
            asm volatile("s_waitcnt vmcnt(0)" ::: "memory");
        } else {
            XB_SPIN(xb_ld(&bar[XB_XGEN(b.x)]) == gen, bar);
            __builtin_amdgcn_fence(__ATOMIC_ACQUIRE, "agent");
            asm volatile("s_waitcnt vmcnt(0)" ::: "memory");
        }
    }
    __syncthreads();
}

namespace pg8 {
constexpr int BM = 256, BK = 64, HALF = 128, HTB = HALF * BK * 2, STAGE_BYTES = 8 * HTB, NXCD = 8, WGM = 8;
__device__ __forceinline__ int lds_byte(int r, int c) { const int st = (r >> 4) * 2 + (c >> 5), rr = r & 15, cc = c & 31, ob = rr * 64 + cc * 2; return st * 1024 + (ob ^ (((ob >> 9) & 1) << 5)); }
__device__ __forceinline__ void stage_rc(int b, int& R, int& C) { const int st = b / 1024, sb = b % 1024, swz = sb ^ (((sb >> 9) & 1) << 5); R = (st >> 1) * 16 + swz / 64; C = (st & 1) * 32 + (swz % 64) / 2; }
__device__ __forceinline__ int perm32(int rho) { const int n = rho >> 4, i = rho & 15; return 8 * (i >> 2) + 4 * n + (i & 3); }

struct Unit { const char* A; const char* B; int pm, pn, seg, aux; };

__device__ __forceinline__ bool tile_of(long L, int nM, int nN, int& pm, int& pn) {
    const int nwg = nM * nN; if (L >= nwg) return false;
    int wgid = (int)L; { const int q = nwg / NXCD, r = nwg % NXCD, xcd = wgid % NXCD, off = wgid / NXCD; wgid = (xcd < r ? xcd * (q + 1) : r * (q + 1) + (xcd - r) * q) + off; }
    const int nig = WGM * nN, gid = wgid / nig, fm = gid * WGM, gsz = (nM - fm) < WGM ? (nM - fm) : WGM;
    pm = fm + ((wgid % nig) % gsz); pn = (wgid % nig) / gsz; return true;
}

template <bool F8, class Epi, class Sched>
__device__ __forceinline__ void gemm_phase(LAS unsigned char* lds, const int lda, const int ldb, const int nt, const Sched& S, const Epi& E) {
    const int tid = otid(), wid = __builtin_amdgcn_readfirstlane(tid >> 6), lane = tid & 63, wr = wid >> 2, wc = wid & 3, fr = lane & 15, fq = lane >> 4;
    unsigned voffA[2], voffB[2];
#pragma unroll
    for (int i = 0; i < 2; ++i) { int R, C; stage_rc(tid * 16 + i * 8192, R, C); const int Rb = Epi::PERM ? ((R & ~31) + perm32(R & 31)) : R;
        voffA[i] = (unsigned)(R * lda + C * 2); voffB[i] = (unsigned)(Rb * ldb + C * 2); }
    const size_t kstep = (size_t)(BK * 2);
    const size_t hstepA = (size_t)HALF * lda, hstepB = (size_t)HALF * ldb;
    const unsigned ldsw = (unsigned)wid * 1024u;
    const int aoff = lds_byte(wr * 64 + fr, fq * 8), boff = lds_byte(wc * 32 + fr, fq * 8);
#define PG8_SA(b, h) (((b) * 2 + (h)) * HTB)
#define PG8_SB(b, h) ((4 + (b) * 2 + (h)) * HTB)
#define PG8_STAGE(bufoff, gbase, voff) do { _Pragma("unroll") for (int _i = 0; _i < 2; ++_i) \
        __builtin_amdgcn_global_load_lds((const unsigned*)((const char*)(gbase) + (voff)[_i]), (LAS unsigned*)(lds + (bufoff) + ldsw + _i * 8192), 16, 0, 0); } while (0)
#define PG8_LDA(dst, b, h) do { _Pragma("unroll") for (int m = 0; m < 4; ++m) { const i32x4v lo_ = *(const LAS i32x4v*)(lds + PG8_SA(b, h) + aoff + m * 2048), hi_ = *(const LAS i32x4v*)(lds + PG8_SA(b, h) + aoff + m * 2048 + 1024); \
        dst[m] = __builtin_shufflevector(lo_, hi_, 0, 1, 2, 3, 4, 5, 6, 7); } } while (0)
#define PG8_LDB(dst, b, h) do { _Pragma("unroll") for (int n = 0; n < 2; ++n) { const i32x4v lo_ = *(const LAS i32x4v*)(lds + PG8_SB(b, h) + boff + n * 2048), hi_ = *(const LAS i32x4v*)(lds + PG8_SB(b, h) + boff + n * 2048 + 1024); \
        dst[n] = __builtin_shufflevector(lo_, hi_, 0, 1, 2, 3, 4, 5, 6, 7); } } while (0)
#define PG8_MMA(ai, bj, At, Bt) do { __builtin_amdgcn_s_setprio(1); _Pragma("unroll") for (int m = 0; m < 4; ++m) _Pragma("unroll") for (int n = 0; n < 2; ++n) { \
        if constexpr (F8) asm volatile("v_mfma_scale_f32_16x16x128_f8f6f4 %0, %1, %2, %0, %3, %4 op_sel_hi:[0,0,0]" : "+v"(acc[ai][bj][m][n]) : "v"(Bt[n]), "v"(At[m]), "v"(scl_w), "v"(scl_a)); \
        else { acc[ai][bj][m][n] = __builtin_amdgcn_mfma_f32_16x16x32_bf16((bf16x8)__builtin_shufflevector(Bt[n], Bt[n], 0, 1, 2, 3), (bf16x8)__builtin_shufflevector(At[m], At[m], 0, 1, 2, 3), acc[ai][bj][m][n], 0, 0, 0); \
               acc[ai][bj][m][n] = __builtin_amdgcn_mfma_f32_16x16x32_bf16((bf16x8)__builtin_shufflevector(Bt[n], Bt[n], 4, 5, 6, 7), (bf16x8)__builtin_shufflevector(At[m], At[m], 4, 5, 6, 7), acc[ai][bj][m][n], 0, 0, 0); } } \
        __builtin_amdgcn_s_setprio(0); } while (0)
#define PG8_WAIT_V(n) asm volatile("s_waitcnt vmcnt(" #n ")" ::: "memory")
#define PG8_WAIT_L(n) asm volatile("s_waitcnt lgkmcnt(" #n ")" ::: "memory")
#define PG8_BAR __builtin_amdgcn_s_barrier()
#define PG8_SCHED __builtin_amdgcn_sched_barrier(0)
    Unit cur, nxt; int ui = 0;
    if (!S.next(0, cur)) return;
    f32x4 acc[2][2][4][2];
#pragma unroll
    for (int a = 0; a < 2; ++a)
#pragma unroll
        for (int b = 0; b < 2; ++b)
#pragma unroll
            for (int m = 0; m < 4; ++m)
#pragma unroll
                for (int n = 0; n < 2; ++n) acc[a][b][m][n] = (f32x4){0.f, 0.f, 0.f, 0.f};
    typedef int i32x4v __attribute__((ext_vector_type(4))); typedef int i32x8v __attribute__((ext_vector_type(8)));
    i32x8v At[4], B0[2], B1[2];
    const int scl_w = 0x79797979, scl_a = 0x7f7f7f7f;
    const char* cA = cur.A; const char* cB = cur.B;
    PG8_STAGE(PG8_SB(0, 0), cB, voffB); PG8_STAGE(PG8_SA(0, 0), cA, voffA); PG8_STAGE(PG8_SB(0, 1), cB + hstepB, voffB); PG8_STAGE(PG8_SA(0, 1), cA + hstepA, voffA);
    if (wr == 1) PG8_BAR;
    PG8_WAIT_V(4); PG8_BAR;
    PG8_STAGE(PG8_SB(1, 0), cB + kstep, voffB); PG8_STAGE(PG8_SA(1, 0), cA + kstep, voffA); PG8_STAGE(PG8_SB(1, 1), cB + hstepB + kstep, voffB);
    PG8_WAIT_V(6); PG8_BAR;
    for (;;) {
        const bool has_next = S.next(ui + 1, nxt);
        const char* nA = has_next ? nxt.A : cA; const char* nB = has_next ? nxt.B : cB;
#pragma nounroll
        for (int t = 0; t < nt; t += 2) {
            const bool last = (t == nt - 2);
            const char* a1 = cA + (size_t)(t + 1) * kstep;
            const char* a2 = last ? nA : cA + (size_t)(t + 2) * kstep; const char* b2 = last ? nB : cB + (size_t)(t + 2) * kstep;
            const char* a3 = a2 + kstep; const char* b3 = b2 + kstep;
            PG8_LDB(B0, 0, 0); PG8_SCHED; PG8_LDA(At, 0, 0); PG8_STAGE(PG8_SA(1, 1), a1 + hstepA, voffA);
            PG8_WAIT_L(8); PG8_BAR; PG8_WAIT_L(0); PG8_MMA(0, 0, At, B0); PG8_BAR; PG8_SCHED;
            PG8_LDB(B1, 0, 1); PG8_STAGE(PG8_SB(0, 0), b2, voffB);
            PG8_BAR; PG8_WAIT_L(0); PG8_MMA(0, 1, At, B1); PG8_BAR;
            PG8_LDA(At, 0, 1); PG8_STAGE(PG8_SA(0, 0), a2, voffA);
            PG8_BAR; PG8_WAIT_L(0); PG8_MMA(1, 0, At, B0); PG8_BAR; PG8_SCHED;
            PG8_STAGE(PG8_SB(0, 1), b2 + hstepB, voffB);
            PG8_WAIT_V(6); PG8_BAR; PG8_MMA(1, 1, At, B1); PG8_BAR;
            PG8_LDB(B0, 1, 0); PG8_SCHED; PG8_LDA(At, 1, 0); PG8_STAGE(PG8_SA(0, 1), a2 + hstepA, voffA);
            PG8_WAIT_L(8); PG8_BAR; PG8_WAIT_L(0); PG8_MMA(0, 0, At, B0); PG8_BAR; PG8_SCHED;
            PG8_LDB(B1, 1, 1); PG8_STAGE(PG8_SB(1, 0), b3, voffB);
            PG8_BAR; PG8_WAIT_L(0); PG8_MMA(0, 1, At, B1); PG8_BAR;
            PG8_LDA(At, 1, 1); PG8_STAGE(PG8_SA(1, 0), a3, voffA);
            PG8_BAR; PG8_WAIT_L(0); PG8_MMA(1, 0, At, B0); PG8_BAR; PG8_SCHED;
            PG8_STAGE(PG8_SB(1, 1), b3 + hstepB, voffB);
            PG8_WAIT_V(6); PG8_BAR; PG8_MMA(1, 1, At, B1); PG8_BAR;
        }
        if constexpr (F8) asm volatile("s_nop 15\n\ts_nop 15" ::: "memory");
        { int tz = threadIdx.x; asm volatile("" : "+v"(tz)); const int wid2 = tz >> 6, lane2 = tz & 63; E(acc, cur, wid2 >> 2, wid2 & 3, lane2 & 15, lane2 >> 4); }
        if (!has_next) break;
        if (S.zero_after(cur)) {
#pragma unroll
            for (int a = 0; a < 2; ++a)
#pragma unroll
                for (int b = 0; b < 2; ++b)
#pragma unroll
                    for (int m = 0; m < 4; ++m)
#pragma unroll
                        for (int n = 0; n < 2; ++n) acc[a][b][m][n] = (f32x4){0.f, 0.f, 0.f, 0.f};
        }
        cur = nxt; cA = nA; cB = nB; ++ui;
    }
    PG8_WAIT_V(0);
    if (wr == 0) PG8_BAR;
    PG8_BAR;
#undef PG8_SA
#undef PG8_SB
#undef PG8_STAGE
#undef PG8_LDA
#undef PG8_LDB
#undef PG8_MMA
#undef PG8_WAIT_V
#undef PG8_WAIT_L
#undef PG8_BAR
#undef PG8_SCHED
}

typedef f32x4 Acc[2][2][4][2];

struct EpiBf16 {
    static constexpr bool PERM = true;
    bf16_t* O; int ldc; const float* bias; int sig_from; bf16_t* GT;
    const float* rope; int rope_lo, rope_hi;
    int prod_lo, prod_hi;
    int gelu_lo, gelu_hi;
    __device__ __forceinline__ void operator()(Acc& acc, const Unit& u, int wr, int wc, int fr, int fq) const {
        const int row0 = u.pm * BM + wr * 64 + fr, col0 = u.pn * BM + wc * 32 + 8 * fq;
        if (u.pn >= prod_lo && u.pn < prod_hi) {
#pragma unroll
            for (int ai = 0; ai < 2; ++ai)
#pragma unroll
                for (int m = 0; m < 4; ++m) { float v[8];
#pragma unroll
                    for (int n = 0; n < 2; ++n)
#pragma unroll
                        for (int j = 0; j < 4; ++j) v[4 * n + j] = acc[ai][0][m][n][j] * acc[ai][1][m][n][j];
                    *(u32x4*)(O + (size_t)(row0 + ai * HALF + m * 16) * ldc + ZC_AC + (u.pn - prod_lo) * HALF + wc * 32 + 8 * fq) = pack8(v); }
            return;
        }
        if (u.pn >= rope_lo && u.pn < rope_hi) {
            const int t9 = u.pm % 9; const bool isctx = (t9 == 0);
            const int ax = fq >> 1, i0 = (fq & 1) * 8, ncol = u.pn * BM + wc * 64 + ax * 32 + i0;
            const float* RC = rope; const float* RS = rope + 2048 * 32;
#pragma unroll
            for (int ai = 0; ai < 2; ++ai)
#pragma unroll
                for (int m = 0; m < 4; ++m) { const int rt = ai * HALF + wr * 64 + m * 16 + fr, t = isctx ? 0 : (t9 - 1) * 256 + rt;
                    const float* cp = RC + t * 32 + ax * 16 + i0; const float* sp = RS + t * 32 + ax * 16 + i0;
                    const f32x4 c0 = *(const f32x4*)cp, c1 = *(const f32x4*)(cp + 4), s0 = *(const f32x4*)sp, s1 = *(const f32x4*)(sp + 4);
                    float o1[8], o2[8];
#pragma unroll
                    for (int j = 0; j < 4; ++j) {
                        const float ca = isctx ? 1.f : c0[j], sa = isctx ? 0.f : s0[j], cb = isctx ? 1.f : c1[j], sb = isctx ? 0.f : s1[j];
                        const float x1a = acc[ai][0][m][0][j], x2a = acc[ai][1][m][0][j], x1b = acc[ai][0][m][1][j], x2b = acc[ai][1][m][1][j];
                        o1[j] = x1a * ca - x2a * sa; o2[j] = x2a * ca + x1a * sa; o1[4 + j] = x1b * cb - x2b * sb; o2[4 + j] = x2b * cb + x1b * sb; }
                    bf16_t* rp = O + (size_t)(u.pm * BM + rt) * ldc + ncol;
                    *(u32x4*)rp = pack8(o1); *(u32x4*)(rp + 16) = pack8(o2); }
            return;
        }
        f32x4 bv[2][2];
#pragma unroll
        for (int bj = 0; bj < 2; ++bj)
#pragma unroll
            for (int n = 0; n < 2; ++n) bv[bj][n] = bias ? *(const f32x4*)(bias + col0 + bj * HALF + 4 * n) : (f32x4){0.f, 0.f, 0.f, 0.f};
#pragma unroll
        for (int ai = 0; ai < 2; ++ai)
#pragma unroll
            for (int m = 0; m < 4; ++m) { bf16_t* rowp = O + (size_t)(row0 + ai * HALF + m * 16) * ldc + col0;
#pragma unroll
                for (int bj = 0; bj < 2; ++bj) { f32x4 v0 = acc[ai][bj][m][0] + bv[bj][0], v1 = acc[ai][bj][m][1] + bv[bj][1];
                    if (u.pn >= sig_from) {
#pragma unroll
                        for (int j = 0; j < 4; ++j) { v0[j] = sigmoidf_(v0[j]); v1[j] = sigmoidf_(v1[j]); } }
                    if (u.pn >= gelu_lo && u.pn < gelu_hi) {
#pragma unroll
                        for (int j = 0; j < 4; ++j) { v0[j] = v0[j] * sigmoidf_(1.5957691216057308f * (v0[j] + 0.044715f * v0[j] * v0[j] * v0[j])); v1[j] = v1[j] * sigmoidf_(1.5957691216057308f * (v1[j] + 0.044715f * v1[j] * v1[j] * v1[j])); } }
                    u32x4 w; w.x = cvt_pk_bf16(v0[0], v0[1]); w.y = cvt_pk_bf16(v0[2], v0[3]); w.z = cvt_pk_bf16(v1[0], v1[1]); w.w = cvt_pk_bf16(v1[2], v1[3]);
                    if (u.pn >= sig_from) *(u32x4*)(GT + ((size_t)(u.pm * 12 + (u.pn - sig_from)) * 16 + (ai * 4 + m) * 2 + bj) * 4096 + (((wr * 4 + wc) * 4 + fq) * 16 + fr) * 8) = w;
                    else *(u32x4*)(rowp + bj * HALF) = w; } }
    }
};

template <bool F8OUT>
struct EpiSwiglu {
    static constexpr bool PERM = true;
    bf16_t* O;
    __device__ __forceinline__ void operator()(Acc& acc, const Unit& u, int wr, int wc, int fr, int fq) const {
        const int row0 = u.pm * BM + wr * 64 + fr, col0 = u.pn * HALF + wc * 32 + 8 * fq;
#pragma unroll
        for (int ai = 0; ai < 2; ++ai)
#pragma unroll
            for (int m = 0; m < 4; ++m) { bf16_t* rowp = O + (size_t)(row0 + ai * HALF + m * 16) * FF + col0;
                float v[8];
#pragma unroll
                for (int n = 0; n < 2; ++n)
#pragma unroll
                    for (int j = 0; j < 4; ++j) { const float g = acc[ai][0][m][n][j], uu = acc[ai][1][m][n][j]; v[4 * n + j] = g * sigmoidf_(g) * uu; }
                if constexpr (F8OUT) { u32x2 w8; w8.x = pack4_fp8(v[0], v[1], v[2], v[3]); w8.y = pack4_fp8(v[4], v[5], v[6], v[7]);
                    *(u32x2*)((unsigned char*)O + (size_t)(row0 + ai * HALF + m * 16) * FF + col0) = w8; }
                else *(u32x4*)rowp = pack8(v); }
    }
};

struct EpiGate {
    static constexpr bool PERM = true;
    bf16_t* G; const bf16_t* XC; const float* bias; const float* coef;
    __device__ __forceinline__ void operator()(Acc& acc, const Unit& u, int wr, int wc, int fr, int fq) const {
        const int dir = u.pn >> 2, q = u.pn & 3, ch0 = 128 * q + wc * 32 + 8 * fq, row0 = u.pm * BM + wr * 64 + fr;
        const float* bp = bias + u.pn * 256 + wc * 32 + 8 * fq;
        float ba[8], bx[8], cf[8];
        { const f32x4 t0 = *(const f32x4*)bp, t1 = *(const f32x4*)(bp + 4), t2 = *(const f32x4*)(bp + 128), t3 = *(const f32x4*)(bp + 132), c0 = *(const f32x4*)(coef + dir * 512 + ch0), c1 = *(const f32x4*)(coef + dir * 512 + ch0 + 4);
#pragma unroll
          for (int j = 0; j < 4; ++j) { ba[j] = t0[j]; ba[4 + j] = t1[j]; bx[j] = t2[j]; bx[4 + j] = t3[j]; cf[j] = c0[j]; cf[4 + j] = c1[j]; } }
#pragma unroll
        for (int ai = 0; ai < 2; ++ai)
#pragma unroll
            for (int m = 0; m < 4; ++m) { const size_t row = (size_t)(row0 + ai * HALF + m * 16);
                float xc[8], la[8], bb[8]; unpack8(*(const u32x4*)(XC + row * 1024 + dir * 512 + ch0), xc);
#pragma unroll
                for (int n = 0; n < 2; ++n)
#pragma unroll
                    for (int j = 0; j < 4; ++j) { const int e = 4 * n + j;
                        const float rr = sigmoidf_(acc[ai][0][m][n][j] + ba[e]), ii = sigmoidf_(acc[ai][1][m][n][j] + bx[e]);
                        const float l2 = cf[e] * rr, aa = __builtin_amdgcn_exp2f(l2);
                        la[e] = l2; bb[e] = __builtin_amdgcn_sqrtf(fmaxf(1.0f - aa * aa, 0.f)) * (ii * xc[e]); }
                bf16_t* gp = G + row * 2048 + dir * 1024 + 2 * ch0;
                u32x4 w0, w1; w0.x = cvt_pk_bf16(la[0], bb[0]); w0.y = cvt_pk_bf16(la[1], bb[1]); w0.z = cvt_pk_bf16(la[2], bb[2]); w0.w = cvt_pk_bf16(la[3], bb[3]);
                w1.x = cvt_pk_bf16(la[4], bb[4]); w1.y = cvt_pk_bf16(la[5], bb[5]); w1.z = cvt_pk_bf16(la[6], bb[6]); w1.w = cvt_pk_bf16(la[7], bb[7]);
                *(u32x4*)gp = w0; *(u32x4*)(gp + 8) = w1; }
    }
};

struct EpiF32 {
    static constexpr bool PERM = false;
    float* C;
    __device__ __forceinline__ void operator()(Acc& acc, const Unit& u, int wr, int wc, int fr, int fq) const {
        const int row0 = u.pm * BM + wr * 64 + fr, col0 = u.pn * BM + wc * 32 + 4 * fq;
#pragma unroll
        for (int ai = 0; ai < 2; ++ai)
#pragma unroll
            for (int m = 0; m < 4; ++m) { float* rowp = C + (size_t)(row0 + ai * HALF + m * 16) * D + col0;
#pragma unroll
                for (int bj = 0; bj < 2; ++bj)
#pragma unroll
                    for (int n = 0; n < 2; ++n) *(f32x4*)(rowp + bj * HALF + n * 16) = acc[ai][bj][m][n]; }
    }
};

template <bool IN_F32>
struct EpiRes {
    static constexpr bool PERM = true;
    const void* in_lat; const void* in_ctx; bf16_t* out_lat; bf16_t* out_ctx; const float* modg; int c; int cm;
    __device__ __forceinline__ void operator()(Acc& acc, const Unit& u, int wr, int wc, int fr, int fq) const {
        const int s = u.pm / 9, t9 = cm ? 0 : u.pm - 9 * s, b = cm ? u.pm : c * CH + s; const bool isctx = (t9 == 0);
        const size_t base = isctx ? (size_t)b * CTXL * D : ((size_t)b * SEQ + (size_t)(t9 - 1) * 256) * D;
        const void* rin = isctx ? in_ctx : in_lat; bf16_t* rout = (isctx ? out_ctx : out_lat) + base;
        const float* gv = modg + (size_t)(isctx ? 32 : b) * 6144;
        const int rloc = wr * 64 + fr, col0 = u.pn * BM + wc * 32 + 8 * fq;
        f32x4 g4[2][2];
#pragma unroll
        for (int bj = 0; bj < 2; ++bj)
#pragma unroll
            for (int n = 0; n < 2; ++n) g4[bj][n] = *(const f32x4*)(gv + col0 + bj * HALF + n * 4);
#pragma unroll
        for (int ai = 0; ai < 2; ++ai)
#pragma unroll
            for (int m = 0; m < 4; ++m) { const size_t off = (size_t)(rloc + ai * HALF + m * 16) * D + col0;
#pragma unroll
                for (int bj = 0; bj < 2; ++bj) { float r[8];
                    if constexpr (IN_F32) { const f32x4 r0 = *(const f32x4*)((const float*)rin + base + off + bj * HALF), r1 = *(const f32x4*)((const float*)rin + base + off + bj * HALF + 4);
#pragma unroll
                        for (int j = 0; j < 4; ++j) { r[j] = r0[j]; r[4 + j] = r1[j]; } }
                    else unpack8(*(const u32x4*)((const bf16_t*)rin + base + off + bj * HALF), r);
#pragma unroll
                    for (int n = 0; n < 2; ++n)
#pragma unroll
                        for (int j = 0; j < 4; ++j) r[4 * n + j] += g4[bj][n][j] * acc[ai][bj][m][n][j];
                    *(u32x4*)(rout + off + bj * HALF) = pack8(r); }
                asm volatile("" ::: "memory"); }
    }
};

struct EpiMerge {
    static constexpr bool PERM = true;
    const bf16_t* GT; bf16_t* M;
    __device__ __forceinline__ void operator()(Acc& acc, const Unit& u, int wr, int wc, int fr, int fq) const {
        const int row0 = u.pm * BM + wr * 64 + fr, col0 = u.pn * BM + wc * 32 + 8 * fq, seg = u.seg;
        const bf16_t* zt = GT + (size_t)((u.pm * 3 + seg) * 4 + u.pn) * 16 * 4096 + (((wr * 4 + wc) * 4 + fq) * 16 + fr) * 8;
        const size_t dnext = (seg < 2) ? (size_t)4 * 16 * 4096 : 0;
#pragma unroll
        for (int ai = 0; ai < 2; ++ai) {
            u32x4 fw[4][2], dw[4][2];
#pragma unroll
            for (int m = 0; m < 4; ++m)
#pragma unroll
                for (int bj = 0; bj < 2; ++bj) { fw[m][bj] = *(const u32x4*)(zt + ((ai * 4 + m) * 2 + bj) * 4096); dw[m][bj] = *(const u32x4*)(zt + dnext + ((ai * 4 + m) * 2 + bj) * 4096); }
#pragma unroll
            for (int m = 0; m < 4; ++m) { const size_t row = (size_t)(row0 + ai * HALF + m * 16);
#pragma unroll
                for (int bj = 0; bj < 2; ++bj) {
                    float f[8], d[8]; unpack8(fw[m][bj], f); unpack8(dw[m][bj], d);
#pragma unroll
                    for (int j = 0; j < 8; ++j) f[j] = (seg < 2) ? f[j] * frcp(d[j]) : f[j];
#pragma unroll
                    for (int n = 0; n < 2; ++n)
#pragma unroll
                        for (int j = 0; j < 4; ++j) acc[ai][bj][m][n][j] *= f[4 * n + j];
                    if (seg == 2) { const f32x4 v0 = acc[ai][bj][m][0], v1 = acc[ai][bj][m][1];
                        u32x4 w; w.x = cvt_pk_bf16(v0[0], v0[1]); w.y = cvt_pk_bf16(v0[2], v0[3]); w.z = cvt_pk_bf16(v1[0], v1[1]); w.w = cvt_pk_bf16(v1[2], v1[3]);
                        *(u32x4*)(M + row * D + col0 + bj * HALF) = w; } } }
        }
    }
};

struct SchedPlain {
    const char* A; const char* B; size_t a_ts, b_ts; int nM, nN, G, c, latonly;
    __device__ __forceinline__ bool next(int i, Unit& u) const {
        int pm, pn; if (!tile_of((long)i * G + c, nM, nN, pm, pn)) return false;
        if (latonly) pm = 9 * (pm >> 3) + 1 + (pm & 7);
        u.pm = pm; u.pn = pn; u.seg = 0; u.aux = 0; u.A = A + (size_t)pm * a_ts; u.B = B + (size_t)pn * b_ts; return true;
    }
    __device__ __forceinline__ bool zero_after(const Unit&) const { return true; }
};
struct SchedGate {
    const char* A; const char* B; int G, c;
    __device__ __forceinline__ bool next(int i, Unit& u) const {
        int pm, pn; if (!tile_of((long)i * G + c, CTILES, 8, pm, pn)) return false;
        u.pm = pm; u.pn = pn; u.seg = 0; u.aux = 0;
        u.A = A + (size_t)pm * (256 * 1024 * 2) + (size_t)(((pn >> 2) * 512 + ((pn & 3) >> 1) * 256) * 2); u.B = B + (size_t)pn * (256 * 256 * 2); return true;
    }
    __device__ __forceinline__ bool zero_after(const Unit&) const { return true; }
};
struct SchedMerge {
    const char* A; const char* B; int nM, G, c, latonly;
    __device__ __forceinline__ bool next(int i, Unit& u) const {
        const int ti = i / 3, seg = i - 3 * ti; int pm, pn; if (!tile_of((long)ti * G + c, nM, 4, pm, pn)) return false;
        if (latonly) pm = 9 * (pm >> 3) + 1 + (pm & 7);
        u.pm = pm; u.pn = pn; u.seg = seg; u.aux = 0;
        u.A = A + (size_t)pm * (256 * 1536 * 2) + (size_t)seg * 1024; u.B = B + (size_t)pn * (256 * 1536 * 2) + (size_t)seg * 1024; return true;
    }
    __device__ __forceinline__ bool zero_after(const Unit& u) const { return u.seg == 2; }
};
struct SchedMoe {
    const char* A; const char* B; size_t a_ts, b_ts, e_stride; int nM, nN, G, c; int pe[8];
    __device__ __forceinline__ bool next(int i, Unit& u) const {
        int pm, pn; if (!tile_of((long)i * G + c, nM, nN, pm, pn)) return false;
        int e = 0;
#pragma unroll
        for (int j = 0; j < 7; ++j) e += (pm * 256 >= pe[j]) ? 1 : 0;
        u.pm = pm; u.pn = pn; u.seg = 0; u.aux = e; u.A = A + (size_t)pm * a_ts; u.B = B + (size_t)e * e_stride + (size_t)pn * b_ts; return true;
    }
    __device__ __forceinline__ bool zero_after(const Unit&) const { return true; }
};
struct SchedMoeSplit {
    const char* A; const char* B; size_t a_ts, b_ts, e_stride; int nR, G, c; int pe[8];
    __device__ __forceinline__ bool next(int i, Unit& u) const {
        const long L = (long)i * G + c; if (L >= (long)nR * 8) return false;
        const int sl = (int)L & 1, pn = ((int)L >> 1) & 3, t = (int)L >> 3, pm = 128 + t;
        int e = 0;
#pragma unroll
        for (int j = 0; j < 7; ++j) e += (pm * 256 >= pe[j]) ? 1 : 0;
        u.pm = sl * 8 + t; u.pn = pn; u.seg = 0; u.aux = e;
        u.A = A + (size_t)pm * a_ts + (size_t)sl * 1792; u.B = B + (size_t)e * e_stride + (size_t)pn * b_ts + (size_t)sl * 1792; return true;
    }
    __device__ __forceinline__ bool zero_after(const Unit&) const { return true; }
};
}

namespace att {
constexpr int NW = 8, QBLK = 32, KVBLK = 64;
constexpr float SCALE = 0.125f;
constexpr float THR = 8.f;
constexpr int LDK = ZLD;
constexpr int SHM_V = KVBLK * 128 * 2, SHM_K = KVBLK * 64 * 2;
#define KSWZ64(row, colB) ((row) * 128 + ((colB) ^ ((((row) >> 1) & 7) << 4)))
#define SBAR() __builtin_amdgcn_sched_barrier(0)
__device__ __forceinline__ int crow(int r, int hi) { return (r & 3) + 8 * (r >> 2) + 4 * hi; }
__device__ __forceinline__ unsigned cvtpk(float lo, float hi) { unsigned r; asm volatile("v_cvt_pk_bf16_f32 %0, %1, %2" : "=v"(r) : "v"(lo), "v"(hi)); return r; }

__device__ __forceinline__ void partialSM(f32x16& p0, f32x16& p1, float& m_reg, float& mn, float& alpha) {
  constexpr float C = SCALE * 1.4426950408889634f;
  float pmax = p0[0];
#pragma unroll
  for (int r = 1; r < 16; ++r) pmax = fmaxf(pmax, p0[r]);
#pragma unroll
  for (int r = 0; r < 16; ++r) pmax = fmaxf(pmax, p1[r]);
  { auto rr = __builtin_amdgcn_permlane32_swap(__float_as_uint(pmax), __float_as_uint(pmax), false, false);
    pmax = fmaxf(__uint_as_float(rr[0]), __uint_as_float(rr[1])); }
  if (__builtin_expect(__all(pmax - m_reg <= THR / SCALE), 1)) { mn = m_reg; alpha = 1.f; }
  else { mn = fmaxf(m_reg, pmax); alpha = __builtin_amdgcn_exp2f((m_reg - mn) * C); m_reg = mn; }
  float mnC = -mn * C;
#pragma unroll
  for (int r = 0; r < 16; ++r) p0[r] = fmaf(p0[r], C, mnC);
#pragma unroll
  for (int r = 0; r < 16; ++r) p1[r] = fmaf(p1[r], C, mnC);
#pragma unroll
  for (int r = 0; r < 16; ++r) p0[r] = __builtin_amdgcn_exp2f(p0[r]);
}
__device__ __forceinline__ void finishSM(f32x16& p0, f32x16& p1, float alpha, float& l_reg, bf16x8& pa0, bf16x8& pa1, bf16x8& pa2, bf16x8& pa3) {
#pragma unroll
  for (int r = 0; r < 16; ++r) p1[r] = __builtin_amdgcn_exp2f(p1[r]);
  float ps = 0;
#pragma unroll
  for (int r = 0; r < 16; ++r) ps += p0[r];
#pragma unroll
  for (int r = 0; r < 16; ++r) ps += p1[r];
  { auto rr = __builtin_amdgcn_permlane32_swap(__float_as_uint(ps), __float_as_uint(ps), false, false);
    ps = __uint_as_float(rr[0]) + __uint_as_float(rr[1]); }
  l_reg = l_reg * alpha + ps;
#define PK4(P, BASE, OUT) do { unsigned a0 = cvtpk(P[BASE + 0], P[BASE + 1]), a1 = cvtpk(P[BASE + 2], P[BASE + 3]);   \
    unsigned b0 = cvtpk(P[BASE + 4], P[BASE + 5]), b1 = cvtpk(P[BASE + 6], P[BASE + 7]);                              \
    auto r0 = __builtin_amdgcn_permlane32_swap(a0, b0, false, false); auto r1 = __builtin_amdgcn_permlane32_swap(a1, b1, false, false); \
    u32x4 w = {r0[0], r1[0], r0[1], r1[1]}; OUT = *reinterpret_cast<bf16x8*>(&w); } while (0)
  PK4(p0, 0, pa0); PK4(p0, 8, pa1); PK4(p1, 0, pa2); PK4(p1, 8, pa3);
#undef PK4
}
__device__ __forceinline__ void qkt(f32x16& p0, f32x16& p1, const char* Ks, const bf16x8 (&qr)[4], int r32, int hi) {
  p0 = f32x16{}; p1 = f32x16{};
#pragma unroll
  for (int d0 = 0; d0 < 4; ++d0) { const int cb = (d0 * 16 + hi * 8) * 2;
    bf16x8 b0 = *reinterpret_cast<const bf16x8*>(Ks + KSWZ64(r32, cb));
    bf16x8 b1 = *reinterpret_cast<const bf16x8*>(Ks + KSWZ64(32 + r32, cb));
    p0 = __builtin_amdgcn_mfma_f32_32x32x16_bf16(b0, qr[d0], p0, 0, 0, 0);
    p1 = __builtin_amdgcn_mfma_f32_32x32x16_bf16(b1, qr[d0], p1, 0, 0, 0); }
}
__device__ __forceinline__ int v_st(int k, int c) { const int kk = (k & ~0xC) | ((k & 4) << 1) | ((k & 8) >> 1); return ((kk >> 3) * 4 + (c >> 5)) * 512 + ((kk & 7) * 32 + (c & 31)) * 2; }
__device__ __forceinline__ int v_rd_base(int lane) { return ((lane & 3) << 3) | (((lane >> 2) & 3) << 6) | (((lane >> 4) & 1) << 5) | (((lane >> 5) & 1) << 8); }
constexpr int v_rd_off(int d0, int ks, int half) { return d0 * 512 + ks * 4096 + half * 2048; }
template <int OFF> __device__ __forceinline__ s16x4 tr_read(int vb) {
  s16x4 r; asm volatile("ds_read_b64_tr_b16 %0, %1 offset:%2" : "=&v"(r) : "v"(vb), "i"(OFF) : "memory"); return r;
}
template <int D0> __device__ __forceinline__ void pv_one(f32x16& od, int vb, bf16x8 pa0, bf16x8 pa1, bf16x8 pa2, bf16x8 pa3) {
  const s16x4 l0 = tr_read<v_rd_off(D0, 0, 0)>(vb), h0 = tr_read<v_rd_off(D0, 0, 1)>(vb), l1 = tr_read<v_rd_off(D0, 1, 0)>(vb), h1 = tr_read<v_rd_off(D0, 1, 1)>(vb);
  const s16x4 l2 = tr_read<v_rd_off(D0, 2, 0)>(vb), h2 = tr_read<v_rd_off(D0, 2, 1)>(vb), l3 = tr_read<v_rd_off(D0, 3, 0)>(vb), h3 = tr_read<v_rd_off(D0, 3, 1)>(vb);
  asm volatile("s_waitcnt lgkmcnt(0)" ::: "memory"); SBAR();
#define PK(L, H) (bf16x8){L[0], L[1], L[2], L[3], H[0], H[1], H[2], H[3]}
  od = __builtin_amdgcn_mfma_f32_32x32x16_bf16(pa0, PK(l0, h0), od, 0, 0, 0);
  od = __builtin_amdgcn_mfma_f32_32x32x16_bf16(pa1, PK(l1, h1), od, 0, 0, 0);
  od = __builtin_amdgcn_mfma_f32_32x32x16_bf16(pa2, PK(l2, h2), od, 0, 0, 0);
  od = __builtin_amdgcn_mfma_f32_32x32x16_bf16(pa3, PK(l3, h3), od, 0, 0, 0);
#undef PK
}
__device__ __forceinline__ void pv_d0(f32x16 (&o)[4], int vb, bf16x8 pa0, bf16x8 pa1, bf16x8 pa2, bf16x8 pa3) {
  pv_one<0>(o[0], vb, pa0, pa1, pa2, pa3); pv_one<1>(o[1], vb, pa0, pa1, pa2, pa3); pv_one<2>(o[2], vb, pa0, pa1, pa2, pa3); pv_one<3>(o[3], vb, pa0, pa1, pa2, pa3);
}

__device__ __forceinline__ void attn_map(const bf16_t* __restrict__ Qb, const bf16_t* __restrict__ Kh, const bf16_t* __restrict__ Vh, int seq, char* lds, f32x16 (&o)[4]) {
  const int tid = otid(), wid = tid >> 6, lane = tid & 63, r32 = lane & 31, hi = lane >> 5;
  char* V_lds = lds; char* K_lds = lds + 2 * SHM_V;
  float* ws = (float*)(lds + 2 * SHM_V + 2 * SHM_K) + wid * 64; float* li_l = ws; float* al_l = ws + 32;
  float m_reg = -1e30f, l_reg = 0; bf16x8 qr[4];
#pragma unroll
  for (int d = 0; d < 4; ++d) o[d] = f32x16{};
  const bf16_t* Qw = Qb + (long)(wid * QBLK + r32) * LDK + hi * 8;
#pragma unroll
  for (int d0 = 0; d0 < 4; ++d0) qr[d0] = *reinterpret_cast<const bf16x8*>(Qw + d0 * 16);
  const int sr = tid >> 4, sc = (tid & 15) * 8, vst0 = v_st(sr, sc), vst1 = v_st(32 + sr, sc);
  const int kr = tid >> 3, kc = (tid & 7) * 8, kst = KSWZ64(kr, kc * 2);
  const int vb0 = (int)(uintptr_t)V_lds + v_rd_base(lane);
  struct { bf16x8 vs0, vs1, ks0; } sr_[2];
#define SLOAD(i, k0) do { sr_[i].vs0 = *reinterpret_cast<const bf16x8*>(&Vh[(long)((k0) + sr) * LDK + sc]); sr_[i].vs1 = *reinterpret_cast<const bf16x8*>(&Vh[(long)((k0) + 32 + sr) * LDK + sc]); \
    sr_[i].ks0 = *reinterpret_cast<const bf16x8*>(&Kh[(long)((k0) + kr) * LDK + kc]); } while (0)
#define SWRITE(b, i) do { *(bf16x8*)(V_lds + (b) * SHM_V + vst0) = sr_[i].vs0; *(bf16x8*)(V_lds + (b) * SHM_V + vst1) = sr_[i].vs1; \
    *(bf16x8*)(K_lds + (b) * SHM_K + kst) = sr_[i].ks0; } while (0)
#define SWAIT() asm volatile("s_waitcnt vmcnt(3)" ::: "memory")
#define RESC(a) do { if (__any((a) < 1.f)) { if (hi == 0) al_l[r32] = (a); asm volatile("s_waitcnt lgkmcnt(0)" ::: "memory"); \
    _Pragma("unroll") for (int d = 0; d < 4; ++d) _Pragma("unroll") for (int r = 0; r < 16; ++r) o[d][r] *= al_l[crow(r, hi)]; } } while (0)
  f32x16 pA0, pA1, pB0, pB1; float mnA, mnB, alA, alB; bf16x8 pa0, pa1, pa2, pa3; const int NT = seq / KVBLK;
  constexpr int SE = 0, SO = 1;
  if (__builtin_amdgcn_readfirstlane(tid) >= 256) __builtin_amdgcn_s_setprio(1);
  SLOAD(SE, 0); asm volatile("s_waitcnt vmcnt(0)" ::: "memory"); SWRITE(0, SE); __syncthreads();
  qkt(pA0, pA1, K_lds, qr, r32, hi); partialSM(pA0, pA1, m_reg, mnA, alA);
  SLOAD(SO, KVBLK); if (2 < NT) SLOAD(SE, 2 * KVBLK);
  SWAIT(); SWRITE(1, SO); __syncthreads();
  for (int j = 1; j + 1 < NT; j += 2) {
    SBAR(); qkt(pB0, pB1, K_lds + SHM_K, qr, r32, hi);
    finishSM(pA0, pA1, alA, l_reg, pa0, pa1, pa2, pa3); SBAR();
    SLOAD(SO, (j + 2) * KVBLK); SBAR();
    pv_d0(o, vb0, pa0, pa1, pa2, pa3); partialSM(pB0, pB1, m_reg, mnB, alB);
    __syncthreads(); SWAIT(); SWRITE(0, SE);
    RESC(alB); __syncthreads();
    SBAR(); qkt(pA0, pA1, K_lds, qr, r32, hi);
    finishSM(pB0, pB1, alB, l_reg, pa0, pa1, pa2, pa3); SBAR();
    if (j + 3 < NT) SLOAD(SE, (j + 3) * KVBLK); SBAR();
    pv_d0(o, vb0 + SHM_V, pa0, pa1, pa2, pa3); partialSM(pA0, pA1, m_reg, mnA, alA);
    __syncthreads(); SWAIT(); SWRITE(1, SO);
    RESC(alA); __syncthreads();
  }
  SBAR(); qkt(pB0, pB1, K_lds + SHM_K, qr, r32, hi);
  finishSM(pA0, pA1, alA, l_reg, pa0, pa1, pa2, pa3); SBAR();
  pv_d0(o, vb0, pa0, pa1, pa2, pa3); partialSM(pB0, pB1, m_reg, mnB, alB);
  __syncthreads(); RESC(alB);
  finishSM(pB0, pB1, alB, l_reg, pa0, pa1, pa2, pa3); SBAR();
  pv_d0(o, vb0 + SHM_V, pa0, pa1, pa2, pa3);
  __builtin_amdgcn_s_setprio(0);
  if (hi == 0) li_l[r32] = l_reg; asm volatile("s_waitcnt lgkmcnt(0)" ::: "memory");
#pragma unroll
  for (int r = 0; r < 16; ++r) { const float rl = __builtin_amdgcn_rcpf(li_l[crow(r, hi)]);
#pragma unroll
    for (int d = 0; d < 4; ++d) o[d][r] *= rl; }
#undef SLOAD
#undef SWRITE
#undef SWAIT
#undef RESC
}
}

struct Args { const float* in[27]; float* out; unsigned char* ws; int ph_lo, ph_hi; };
enum { I_X = 0, I_C, I_CTX, I_CCTX, I_MODW, I_MODB, I_N1W, I_N2W, I_WIN, I_CONVA, I_RGCW, I_RGCB, I_RGWA, I_RGBA, I_RGWX, I_RGBX, I_RGLAM, I_DALAM, I_SUBLN, I_WBR, I_WOUT,
       I_F13, I_F2, I_ROUTER, I_M13, I_M2, I_FNW };

__device__ __forceinline__ void p0_mod(const Args& a, LAS unsigned char* lds) {
    LAS float* S = (LAS float*)lds;
    const int tid = otid(), wave = tid >> 6, lane = tid & 63;
    float* MOD = (float*)(a.ws + WS_MOD);
    for (int item = blockIdx.x; item < 192; item += gridDim.x) {
        const int l = item / 96, cb = item - 96 * l, j = cb * 64 + lane;
        for (int i = tid; i < 33 * 1024; i += NTHREADS) { const int r = i >> 10, k = i & 1023; const float v = (r < 32) ? a.in[I_C][r * 1024 + k] : a.in[I_CCTX][k]; S[i] = v * sigmoidf_(v); }
        __syncthreads();
        float acc[33];
#pragma unroll
        for (int r = 0; r < 33; ++r) acc[r] = 0.f;
        const float* wp = a.in[I_MODW] + (size_t)l * 1024 * 6144 + j;
        for (int k = wave * 128; k < wave * 128 + 128; k += 4) {
            const float w0 = wp[(size_t)k * 6144], w1 = wp[(size_t)(k + 1) * 6144], w2 = wp[(size_t)(k + 2) * 6144], w3 = wp[(size_t)(k + 3) * 6144];
#pragma unroll
            for (int r = 0; r < 33; ++r) { const f32x4 s = *(const LAS f32x4*)(S + r * 1024 + k); acc[r] += s[0] * w0 + s[1] * w1 + s[2] * w2 + s[3] * w3; }
        }
        __syncthreads();
#pragma unroll
        for (int r = 0; r < 33; ++r) S[(wave * 33 + r) * 64 + lane] = acc[r];
        __syncthreads();
        for (int o = tid; o < 33 * 64; o += NTHREADS) { const int r = o >> 6, ln = o & 63; float s = a.in[I_MODB][l * 6144 + cb * 64 + ln];
#pragma unroll
            for (int w = 0; w < 8; ++w) s += S[(w * 33 + r) * 64 + ln];
            MOD[((size_t)l * 33 + r) * 6144 + cb * 64 + ln] = s; }
        __syncthreads();
    }
}
__device__ __forceinline__ void cvt_mat(LAS unsigned char* lds, const float* src, int K, int N, bf16_t* dst, int ldd, int coff, int mode, int rot, bool f8 = false) {
    LAS float* T = (LAS float*)lds;
    const int tid = otid(), tn = N / 64, nt = (K / 64) * tn, G = gridDim.x;
    for (int t = (blockIdx.x + rot) % G; t < nt; t += G) {
        const int k0 = (t / tn) * 64, n0 = (t % tn) * 64;
#pragma unroll
        for (int i = 0; i < 8; ++i) { const int k = (tid >> 6) + 8 * i, n = tid & 63; T[k * 65 + n] = __builtin_nontemporal_load(src + (size_t)(k0 + k) * N + n0 + n); }
        __syncthreads();
        { const int n = tid >> 3, k8 = (tid & 7) * 8; float v[8];
#pragma unroll
          for (int j = 0; j < 8; ++j) v[j] = T[(k8 + j) * 65 + n];
          const int nn = n0 + n; int nd = nn;
          if (mode == 1) { const int q = (nn < FF) ? nn : nn - FF; nd = 256 * (q >> 7) + (q & 127) + ((nn < FF) ? 0 : 128); }
          if (mode == 2 && nn >= ZC_AC && nn < ZC_RG) {
              const int c = nn - ZC_AC, chn = c & 511; nd = ZC_AC + (chn >> 7) * 256 + (c >= 512 ? 128 : 0) + (chn & 127); }
          if (mode == 2 && nn >= ZC_Q && nn < ZC_V) {
              const int j = nn & 255, vec = j >> 6, d = j & 63; nd = (nn & ~255) + ((d >> 4) & 1) * 128 + vec * 32 + (d >> 5) * 16 + (d & 15); }
          if (f8) { u32x2 w8; w8.x = pack4_fp8(v[0] * 64.f, v[1] * 64.f, v[2] * 64.f, v[3] * 64.f); w8.y = pack4_fp8(v[4] * 64.f, v[5] * 64.f, v[6] * 64.f, v[7] * 64.f);
              *(u32x2*)((unsigned char*)dst + (size_t)nd * ldd + coff + k0 + k8) = w8; }
          else *(u32x4*)(dst + (size_t)nd * ldd + coff + k0 + k8) = pack8(v); }
        __syncthreads();
    }
}
__device__ __forceinline__ void p0_misc(const Args& a) {
    const int gtid = blockIdx.x * NTHREADS + otid(), gsz = gridDim.x * NTHREADS;
    bf16_t* WG = (bf16_t*)(a.ws + WS_WG);
    for (int i = gtid; i < 2 * 8 * 256 * 32; i += gsz) {
        const int k8 = (i & 31) * 8, n = (i >> 5) & 255, t8 = (i >> 13) & 7, l = i >> 16;
        const int dir = t8 >> 2, q = t8 & 3, gate = n >> 7, ch = 128 * q + (n & 127), g = ch >> 6, j = ch & 63, inch = 256 * (q >> 1) + k8, gk = inch >> 6, i0 = inch & 63;
        const float* w = (gate ? a.in[I_RGWX] : a.in[I_RGWA]) + (((size_t)(l * 2 + dir) * 8 + g) * 64) * 64;
        float v[8];
#pragma unroll
        for (int qq = 0; qq < 8; ++qq) v[qq] = (g == gk) ? w[(i0 + qq) * 64 + j] : 0.f;
        *(u32x4*)(WG + (size_t)i * 8) = pack8(v);
    }
    float* GB = (float*)(a.ws + WS_GB);
    for (int i = gtid; i < 2 * 2048; i += gsz) { const int l = i >> 11, col = i & 2047, t8 = col >> 8, n = col & 255, dir = t8 >> 2, q = t8 & 3, gate = n >> 7, ch = 128 * q + (n & 127);
        GB[i] = (gate ? a.in[I_RGBX] : a.in[I_RGBA])[(l * 2 + dir) * 512 + ch]; }
    float* CF = (float*)(a.ws + WS_COEF);
    for (int i = gtid; i < 2 * 1024; i += gsz) { const float lam = a.in[I_RGLAM][i]; CF[i] = -8.0f * log1pf(expf(-lam)) * 1.4426950408889634f; }
    float* RC = (float*)(a.ws + WS_ROPE); float* RS = RC + 2048 * 32;
    for (int i = gtid; i < 2048 * 32; i += gsz) { const int t = i >> 5, ax = (i >> 4) & 1, q = i & 15;
        const float inv = powf(10000.0f, -(float)(2 * q) / 32.0f); const float pos = (float)(ax ? (t & 63) : (t >> 6)); const float ang = pos * inv;
        RC[i] = cosf(ang); RS[i] = sinf(ang); }
    if (gtid < 2) { const int l = gtid; const float* lf = a.in[I_DALAM] + l * 256; float s1 = 0.f, s2 = 0.f;
        for (int q = 0; q < 64; ++q) { s1 += lf[q] * lf[64 + q]; s2 += lf[128 + q] * lf[192 + q]; }
        const float lam_init = 0.8f - 0.6f * expf(-0.3f * (float)l);
        ((float*)(a.ws + WS_LAM))[l] = expf(s1) - expf(s2) + lam_init; }
}
__device__ __forceinline__ void phase_prologue(const Args& a, LAS unsigned char* lds) {
    p0_mod(a, lds);
    __syncthreads();
    unsigned char* ws = a.ws; int rot = 0;
    for (int l = 0; l < 2; ++l) {
        cvt_mat(lds, a.in[I_WIN] + (size_t)l * D * DIN, D, DIN, (bf16_t*)(ws + WS_WIN) + (size_t)l * DIN * D, D, 0, 2, rot); rot += 64;
        for (int br = 0; br < 3; ++br) { cvt_mat(lds, a.in[I_WBR] + ((size_t)l * 3 + br) * 512 * D, 512, D, (bf16_t*)(ws + WS_WBR) + (size_t)l * D * 1536, 1536, br * 512, 0, rot); rot += 128; }
        cvt_mat(lds, a.in[I_WOUT] + (size_t)l * D * D, D, D, (bf16_t*)(ws + WS_WOUT) + (size_t)l * D * D, D, 0, 0, rot); rot += 64;
    }
    cvt_mat(lds, a.in[I_F13], D, DIN, (bf16_t*)(ws + WS_F13), D, 0, 1, rot, DENSE_F8);
    cvt_mat(lds, a.in[I_F2], FF, D, (bf16_t*)(ws + WS_F2), FF, 0, 0, rot + 128, DENSE_F8);
    for (int e = 0; e < NEXP; ++e) {
        cvt_mat(lds, a.in[I_M13] + (size_t)e * D * DIN, D, DIN, (bf16_t*)(ws + WS_M13 + (size_t)e * DIN * D), D, 0, 1, e * 32, true);
        cvt_mat(lds, a.in[I_M2] + (size_t)e * FF * D, FF, D, (bf16_t*)(ws + WS_M2 + (size_t)e * D * FF), FF, 0, 0, e * 32 + 16, true);
    }
    p0_misc(a);
}

template <bool ROUTER>
__device__ __forceinline__ void phase_norm(const Args& a, int l, int c, int which, bool skipctx, LAS unsigned char* lds, bool probe = false, bool ctxall = false) {
    const int tid = otid(), wave = tid >> 6, lane = tid & 63;
    LAS int* hist = (LAS int*)lds;
    if (ROUTER) { if (tid < 16) hist[tid] = 0; __syncthreads(); }
    const float* MOD = (const float*)(a.ws + WS_MOD) + (size_t)l * 33 * 6144;
    const float* nw = (which ? a.in[I_N2W] : a.in[I_N1W]) + l * D;
    const bool first = (l == 0 && which == 0);
    const float* lat_src = a.in[I_X]; const float* ctx_src = a.in[I_CTX];
    const bf16_t* lat_b = (const bf16_t*)(a.ws + WS_XB); const bf16_t* ctx_b = (const bf16_t*)(a.ws + WS_CX);
    bf16_t* U = (bf16_t*)(a.ws + WS_U);
    f32x4 nwv[4];
#pragma unroll
    for (int i = 0; i < 4; ++i) nwv[i] = *(const f32x4*)(nw + lane * 4 + 256 * i);
    f32x4 rw[4][4][2];
    if (ROUTER) {
#pragma unroll
        for (int i = 0; i < 4; ++i)
#pragma unroll
            for (int q = 0; q < 4; ++q) { const float* rp = a.in[I_ROUTER] + (size_t)(lane * 4 + 256 * i + q) * 8; rw[i][q][0] = *(const f32x4*)rp; rw[i][q][1] = *(const f32x4*)(rp + 4); } }
    const int nrows = ctxall ? NB * CTXL : CROWS;
#define NORM_LOADROW(RR, RAW) do { const int r_ = (RR); const int s_ = ctxall ? (r_ >> 8) : r_ / TOK, w_ = ctxall ? (r_ & 255) : r_ - s_ * TOK, b_ = ctxall ? s_ : c * CH + s_; const bool ic_ = w_ < CTXL; \
        const size_t so_ = ic_ ? ((size_t)b_ * CTXL + w_) * D : ((size_t)b_ * SEQ + (w_ - CTXL)) * D; \
        if (first) { const float* sp_ = (ic_ ? ctx_src : lat_src) + so_ + lane * 4; _Pragma("unroll") for (int i = 0; i < 4; ++i) RAW[i] = *(const u32x4*)(sp_ + 256 * i); } \
        else { const bf16_t* sp_ = (ic_ ? ctx_b : lat_b) + so_ + lane * 4; _Pragma("unroll") for (int i = 0; i < 4; ++i) { const u32x2 t_ = *(const u32x2*)(sp_ + 256 * i); RAW[i] = (u32x4){t_.x, t_.y, 0u, 0u}; } } } while (0)
    u32x4 rawc[4], rawn[4];
    const int rstride = gridDim.x * 8, rfirst = blockIdx.x * 8 + wave;
    if (rfirst < nrows) NORM_LOADROW(rfirst, rawc);
    for (int r = rfirst; r < nrows; r += rstride) {
        { const int rn = (r + rstride < nrows) ? r + rstride : r; NORM_LOADROW(rn, rawn); }
        const int s = ctxall ? (r >> 8) : r / TOK, w = ctxall ? (r & 255) : r - s * TOK, b = ctxall ? s : c * CH + s; const bool isctx = w < CTXL;
        f32x4 v[4]; float ss = 0.f;
#pragma unroll
        for (int i = 0; i < 4; ++i) {
            if (first) v[i] = (f32x4){__uint_as_float(rawc[i].x), __uint_as_float(rawc[i].y), __uint_as_float(rawc[i].z), __uint_as_float(rawc[i].w)};
            else v[i] = (f32x4){__uint_as_float(rawc[i].x << 16), __uint_as_float(rawc[i].x & 0xffff0000u), __uint_as_float(rawc[i].y << 16), __uint_as_float(rawc[i].y & 0xffff0000u)};
            ss += v[i][0] * v[i][0] + v[i][1] * v[i][1] + v[i][2] * v[i][2] + v[i][3] * v[i][3]; }
#pragma unroll
        for (int i = 0; i < 4; ++i) rawc[i] = rawn[i];
        if (skipctx && isctx) continue;
        ss = wave_sum(ss);
        const float rstd = 1.0f / sqrtf(ss * (1.0f / 1024.0f) + EPS);
        const float* mr = MOD + (size_t)(isctx ? 32 : b) * 6144 + which * 3072;
        float lg[8];
        if (ROUTER) {
#pragma unroll
            for (int e = 0; e < 8; ++e) lg[e] = 0.f; }
#pragma unroll
        for (int i = 0; i < 4; ++i) { const int col = lane * 4 + 256 * i;
            const f32x4 sh = *(const f32x4*)(mr + col), sc = *(const f32x4*)(mr + 1024 + col);
            f32x4 h = (v[i] * rstd * nwv[i]) * (sc + 1.0f) + sh;
            if (which == 1 && (ROUTER || DENSE_F8)) *(unsigned*)((unsigned char*)U + (size_t)r * D + col) = pack4_fp8(h[0], h[1], h[2], h[3]);
            else { u32x2 pk; pk.x = cvt_pk_bf16(h[0], h[1]); pk.y = cvt_pk_bf16(h[2], h[3]);
                *(u32x2*)(U + (size_t)r * D + col) = pk; }
            if (ROUTER) {
#pragma unroll
                for (int q = 0; q < 4; ++q) { const f32x4 r0 = rw[i][q][0], r1 = rw[i][q][1];
                    lg[0] += h[q] * r0[0]; lg[1] += h[q] * r0[1]; lg[2] += h[q] * r0[2]; lg[3] += h[q] * r0[3];
                    lg[4] += h[q] * r1[0]; lg[5] += h[q] * r1[1]; lg[6] += h[q] * r1[2]; lg[7] += h[q] * r1[3]; } } }
        if (ROUTER) {
#pragma unroll
            for (int e = 0; e < 8; ++e) lg[e] = wave_sum(lg[e]);
            int e0 = 0; float v0 = lg[0];
#pragma unroll
            for (int e = 1; e < 8; ++e) if (lg[e] > v0) { v0 = lg[e]; e0 = e; }
            int e1 = -1; float v1 = -3.0e38f;
#pragma unroll
            for (int e = 0; e < 8; ++e) if (e != e0 && lg[e] > v1) { v1 = lg[e]; e1 = e; }
            const float ex = __expf(v1 - v0), p0 = 1.0f / (1.0f + ex), p1 = ex * p0;
            if (lane == 0) { const int t = s * SEQ + (w - CTXL);
                int* te = (int*)(a.ws + WS_TOKE); float* tp = (float*)(a.ws + WS_TOKP); int* ts = (int*)(a.ws + WS_TOKS);
                te[2 * t] = e0; te[2 * t + 1] = e1; tp[2 * t] = p0; tp[2 * t + 1] = p1;
                ts[2 * t] = __hip_atomic_fetch_add(hist + e0, 1, __ATOMIC_RELAXED, __HIP_MEMORY_SCOPE_WORKGROUP);
                ts[2 * t + 1] = __hip_atomic_fetch_add(hist + e1, 1, __ATOMIC_RELAXED, __HIP_MEMORY_SCOPE_WORKGROUP); }
        }
    }
    if (ROUTER) {
        __syncthreads();
        if (tid < 8) { int* cnt = (int*)(a.ws + WS_CTL + CTL_CNT) + c * 32 + (probe ? 8 : 0); hist[8 + tid] = atomicAdd(cnt + tid, hist[tid]); }
        __syncthreads();
        if (lane == 0) {
            const int* te = (const int*)(a.ws + WS_TOKE); int* ts = (int*)(a.ws + WS_TOKS);
            for (int r = blockIdx.x * 8 + wave; r < CROWS; r += gridDim.x * 8) {
                const int s = r / TOK, w = r - s * TOK; if (w < CTXL) continue;
                const int t = s * SEQ + (w - CTXL);
                ts[2 * t] += hist[8 + te[2 * t]]; ts[2 * t + 1] += hist[8 + te[2 * t + 1]]; }
        }
    }
}

__device__ __forceinline__ void phase_elem(const Args& a, int l, bool probe = false) {
    bf16_t* Z = (bf16_t*)(a.ws + WS_Z); bf16_t* XC = (bf16_t*)(a.ws + WS_XC); bf16_t* YC = (bf16_t*)(a.ws + WS_YCAT);
    const float* caw = a.in[I_CONVA] + (size_t)l * 3 * 512; const float* rcw = a.in[I_RGCW] + (size_t)l * 2 * 4 * 512; const float* rcb = a.in[I_RGCB] + (size_t)l * 2 * 512;
    for (int idx = blockIdx.x * NTHREADS + otid(); idx < CROWS * 64; idx += gridDim.x * NTHREADS) {
        const int r = idx >> 6, cg = idx & 63, ch = cg * 8, w = r % TOK; const bool isctx = w < CTXL; const int lo = isctx ? 0 : CTXL, hi = isctx ? CTXL - 1 : TOK - 1;
        bf16_t* zr = Z + (size_t)r * ZLD;
        {
            float ab[8], acc[8], pc[8];
            unpack8(*(const u32x4*)(zr + ZC_AB + ch), ab);
#pragma unroll
            for (int j = 0; j < 8; ++j) acc[j] = 0.f;
#pragma unroll
            for (int k = 0; k < 3; ++k) { const int ww = w + k - 1;
                if (ww >= lo && ww <= hi) { const bf16_t* zz = zr + (ptrdiff_t)(k - 1) * ZLD;
                    unpack8(*(const u32x4*)(zz + ZC_AC + ch), pc);
                    const f32x4 w0 = *(const f32x4*)(caw + k * 512 + ch), w1 = *(const f32x4*)(caw + k * 512 + ch + 4);
#pragma unroll
                    for (int j = 0; j < 4; ++j) { acc[j] += w0[j] * pc[j]; acc[4 + j] += w1[j] * pc[4 + j]; } } }
#pragma unroll
            for (int j = 0; j < 8; ++j) acc[j] *= ab[j];
            *(u32x4*)(YC + (size_t)r * 1536 + ch) = pack8(acc);
        }
        {
            float xf[8], xb[8], rx[8];
            { const f32x4 b0 = *(const f32x4*)(rcb + ch), b1 = *(const f32x4*)(rcb + ch + 4), c0 = *(const f32x4*)(rcb + 512 + ch), c1 = *(const f32x4*)(rcb + 512 + ch + 4);
#pragma unroll
              for (int j = 0; j < 4; ++j) { xf[j] = b0[j]; xf[4 + j] = b1[j]; xb[j] = c0[j]; xb[4 + j] = c1[j]; } }
#pragma unroll
            for (int o = -3; o <= 3; ++o) { const int ww = w + o;
                if (ww >= lo && ww <= hi) { unpack8(*(const u32x4*)(zr + (ptrdiff_t)o * ZLD + ZC_RX + ch), rx);
                    if (o <= 0) { const f32x4 w0 = *(const f32x4*)(rcw + (o + 3) * 512 + ch), w1 = *(const f32x4*)(rcw + (o + 3) * 512 + ch + 4);
#pragma unroll
                        for (int j = 0; j < 4; ++j) { xf[j] += w0[j] * rx[j]; xf[4 + j] += w1[j] * rx[4 + j]; } }
                    if (o >= 0) { const f32x4 w0 = *(const f32x4*)(rcw + (4 + o) * 512 + ch), w1 = *(const f32x4*)(rcw + (4 + o) * 512 + ch + 4);
#pragma unroll
                        for (int j = 0; j < 4; ++j) { xb[j] += w0[j] * rx[j]; xb[4 + j] += w1[j] * rx[4 + j]; } } } }
            *(u32x4*)(XC + (size_t)r * 1024 + ch) = pack8(xf);
            *(u32x4*)(XC + (size_t)r * 1024 + 512 + ch) = pack8(xb);
        }
    }
}

__device__ __forceinline__ void phase_scan(const Args& a, int l, LAS unsigned char* lds) {
    constexpr int SL = 36, NS = TOK / SL, CG = 8;
    LAS float* SG = (LAS float*)lds;
    LAS float* HL = (LAS float*)(lds + 8192);
    const int tid = otid(), chl = tid & 7, seg = tid >> 3;
    const bf16_t* Z = (const bf16_t*)(a.ws + WS_Z); const bf16_t* Gp = (const bf16_t*)(a.ws + WS_G);
    bf16_t* YC = (bf16_t*)(a.ws + WS_YCAT);
    const int G_ = gridDim.x, bx_ = blockIdx.x, vcu_ = (G_ % 8 == 0) ? (bx_ % 8) * (G_ / 8) + bx_ / 8 : bx_;
    for (int item = vcu_; item < CH * 64; item += G_) {
        const int s = item >> 6, ch = (item & 63) * CG + chl, rowbase = s * TOK;
        for (int dir = 0; dir < 2; ++dir) {
            const int q0 = seg * SL;
            const unsigned* gp = (const unsigned*)(Gp + dir * 1024 + 2 * ch);
            unsigned pk[SL];
#pragma unroll
            for (int j = 0; j < SL; ++j) { int q = q0 + j; asm volatile("" : "+v"(q));
                const int row = rowbase + (dir == 0 ? q : (q < CTXL ? CTXL - 1 - q : TOK + CTXL - 1 - q));
                pk[j] = gp[(size_t)row * 1024]; }
            float A = 1.f, Bv = 0.f;
#pragma unroll
            for (int j = 0; j < SL; ++j) { const float aa = __builtin_amdgcn_exp2f(__uint_as_float(pk[j] << 16)); A *= aa; Bv = aa * Bv + __uint_as_float(pk[j] & 0xffff0000u); }
            SG[(seg * 2) * CG + chl] = A; SG[(seg * 2 + 1) * CG + chl] = Bv;
            __syncthreads();
            float h = 0.f;
            for (int w2 = 0; w2 < seg; ++w2) h = SG[(w2 * 2) * CG + chl] * h + SG[(w2 * 2 + 1) * CG + chl];
            if (dir == 0) {
#pragma unroll
                for (int j = 0; j < SL; ++j) { int q = q0 + j; asm volatile("" : "+v"(q));
                    h = __builtin_amdgcn_exp2f(__uint_as_float(pk[j] << 16)) * h + __uint_as_float(pk[j] & 0xffff0000u); HL[(seg * 37 + j) * CG + chl] = h; }
            } else {
#pragma unroll
                for (int g0 = 0; g0 < SL; g0 += 12) {
                    float rg[12];
#pragma unroll
                    for (int j = 0; j < 12; ++j) { int q = q0 + g0 + j; asm volatile("" : "+v"(q)); const int row = rowbase + (q < CTXL ? CTXL - 1 - q : TOK + CTXL - 1 - q);
                        rg[j] = bf2f(Z[(size_t)row * ZLD + ZC_RG + ch]); }
#pragma unroll
                    for (int j = 0; j < 12; ++j) { int q = q0 + g0 + j; asm volatile("" : "+v"(q)); const int rl = (q < CTXL ? CTXL - 1 - q : TOK + CTXL - 1 - q), sr = rl / SL;
                        h = __builtin_amdgcn_exp2f(__uint_as_float(pk[g0 + j] << 16)) * h + __uint_as_float(pk[g0 + j] & 0xffff0000u);
                        const float hf = HL[(sr * 37 + (rl - sr * SL)) * CG + chl];
                        YC[(size_t)(rowbase + rl) * 1536 + 512 + ch] = f2bf(rg[j] * (hf + h)); }
                }
            }
            __syncthreads();
        }
    }
}

__device__ __forceinline__ void phase_attn(const Args& a, int l, unsigned char* ldsg) {
    const bf16_t* Z = (const bf16_t*)(a.ws + WS_Z); bf16_t* YC = (bf16_t*)(a.ws + WS_YCAT);
    const float lam = ((const float*)(a.ws + WS_LAM))[l];
    const float lam_init = 0.8f - 0.6f * expf(-0.3f * (float)l);
    const float* subw = a.in[I_SUBLN] + l * 128;
    const int G = gridDim.x, bx = blockIdx.x, vcu = (G % 8 == 0) ? (bx % 8) * (G / 8) + bx / 8 : bx;
    const int nitems = CH * 4 * 8 + (l == 0 ? CH * 4 : 0);
    for (int it = 0;; ++it) {
        int item = vcu + (it >> 1) * G; const int map = it & 1;
        if (G == 256 && (it >> 1) == 1) {
            const int k = bx - 64; item = (k >= 0 && k % 6 == 0 && k / 6 < CH * 4) ? CH * 32 + k / 6 : nitems; }
        if (item >= nitems) break;
        int s, h, qrow0, seq;
        if (item < CH * 32) { s = item >> 5; h = (item >> 3) & 3; qrow0 = s * TOK + CTXL + (item & 7) * 256; seq = TOK; }
        else { const int j = item - CH * 32; s = j >> 2; h = j & 3; qrow0 = s * TOK; seq = CTXL; }
        const bf16_t* zk = Z + (size_t)(s * TOK) * ZLD;
        f32x16 o[4];
        __syncthreads();
        att::attn_map(Z + (size_t)qrow0 * ZLD + ZC_Q + h * 128 + map * 64, zk + ZC_K + h * 128 + map * 64, zk + ZC_V + h * 128, seq, (char*)ldsg, o);
        int tz = threadIdx.x; asm volatile("" : "+v"(tz));
        const int wid = tz >> 6, lane = tz & 63, r32 = lane & 31, hi = lane >> 5;
        float* scr = (float*)(a.ws + WS_OSCR) + (size_t)blockIdx.x * 32768 + wid * 4096;
        if (map == 0) {
#pragma unroll
            for (int d = 0; d < 4; ++d)
#pragma unroll
                for (int r = 0; r < 16; ++r) scr[(d * 16 + r) * 64 + lane] = o[d][r];
        } else {
            float ssq[16];
#pragma unroll
            for (int r = 0; r < 16; ++r) ssq[r] = 0.f;
#pragma unroll
            for (int d = 0; d < 4; ++d)
#pragma unroll
                for (int r = 0; r < 16; ++r) { const float v = scr[(d * 16 + r) * 64 + lane] - lam * o[d][r]; o[d][r] = v; ssq[r] += v * v; }
#pragma unroll
            for (int r = 0; r < 16; ++r) {
#pragma unroll
                for (int x = 1; x < 32; x <<= 1) ssq[r] += __shfl_xor(ssq[r], x);
                ssq[r] = (1.0f - lam_init) / sqrtf(ssq[r] * (1.0f / 128.0f) + EPS); }
#pragma unroll
            for (int d = 0; d < 4; ++d) { const float wv = subw[d * 32 + r32];
#pragma unroll
                for (int r = 0; r < 16; ++r) YC[(size_t)(qrow0 + wid * 32 + att::crow(r, hi)) * 1536 + 1024 + h * 128 + d * 32 + r32] = f2bf(o[d][r] * ssq[r] * wv); }
        }
    }
}

__device__ __forceinline__ void copy_ctx_side(const Args& a, int c) {
    const int tid = otid(), wave = tid >> 6, lane = tid & 63;
    const bf16_t* YC = (const bf16_t*)(a.ws + WS_YCAT);
    bf16_t* YCC = (bf16_t*)(a.ws + WS_YCATC); bf16_t* ZGC = (bf16_t*)(a.ws + WS_ZGC);
    for (int i = blockIdx.x * 8 + wave; i < CH * CTXL; i += gridDim.x * 8) {
        const int s = i >> 8, w = i & 255; const size_t row = (size_t)s * TOK + w, grow = (size_t)(c * CH + s) * CTXL + w;
        const u32x4* ys = (const u32x4*)(YC + row * 1536); u32x4* yd = (u32x4*)(YCC + grow * 1536);
#pragma unroll
        for (int q = 0; q < 3; ++q) yd[q * 64 + lane] = ys[q * 64 + lane];
    }
    const u32x4* gt = (const u32x4*)(a.ws + WS_GZT);
    for (int i = blockIdx.x * NTHREADS + tid; i < CH * 12 * 8192; i += gridDim.x * NTHREADS) {
        const int s = i / (12 * 8192), o = i - s * (12 * 8192);
        ((u32x4*)ZGC)[(size_t)(c * CH + s) * (12 * 8192) + o] = gt[(size_t)(9 * s) * (12 * 8192) + o];
    }
}

__device__ __forceinline__ void moe_pad_end(const int* cnt, int (&pe)[8]) {
    int acc = 0;
#pragma unroll
    for (int e = 0; e < 8; ++e) { const int n = __builtin_amdgcn_readfirstlane(__hip_atomic_load(cnt + e, __ATOMIC_RELAXED, __HIP_MEMORY_SCOPE_AGENT)); acc += (n + 255) & ~255; pe[e] = acc; }
}
__device__ __forceinline__ void phase_scatter(const Args& a, int c) {
    const int tid = otid(), wave = tid >> 6, lane = tid & 63;
    int* cnt = (int*)(a.ws + WS_CTL + CTL_CNT) + c * 32;
    int pe[8]; moe_pad_end(cnt, pe);
    const int* te = (const int*)(a.ws + WS_TOKE); const int* ts = (const int*)(a.ws + WS_TOKS); int* tsl = (int*)(a.ws + WS_TSLOT);
    const bf16_t* U = (const bf16_t*)(a.ws + WS_U); bf16_t* HS = (bf16_t*)(a.ws + WS_HS);
    for (int i = blockIdx.x * 8 + wave; i < 2 * MTOK; i += gridDim.x * 8) {
        const int t = i >> 1, e = te[i];
        const int pos = ts[i];
        int ps = 0;
#pragma unroll
        for (int j = 0; j < 7; ++j) ps = (e > j) ? pe[j] : ps;
        const int slot = ps + pos;
        if (lane == 0) tsl[i] = slot;
        const int row = (t >> 11) * TOK + CTXL + (t & 2047);
        const u32x4* src = (const u32x4*)((const unsigned char*)U + (size_t)row * D); u32x4* dst = (u32x4*)((unsigned char*)HS + (size_t)slot * D);
        dst[lane] = src[lane];
    }
}
__device__ __forceinline__ f32x4 ld4bf(const bf16_t* p) { const u32x2 pk = *(const u32x2*)p; return (f32x4){__uint_as_float(pk.x << 16), __uint_as_float(pk.x & 0xffff0000u), __uint_as_float(pk.y << 16), __uint_as_float(pk.y & 0xffff0000u)}; }
__device__ __forceinline__ void phase_combine(const Args& a, int c, bool probe = false) {
    const int tid = otid(), wave = tid >> 6, lane = tid & 63;
    const bf16_t* YS = (const bf16_t*)(a.ws + WS_YS); const int* ts = (const int*)(a.ws + WS_TSLOT); const float* tp = (const float*)(a.ws + WS_TOKP);
    const float* MOD = (const float*)(a.ws + WS_MOD) + (size_t)33 * 6144;
    const float* fw = a.in[I_FNW];
    for (int t = blockIdx.x * 8 + wave; t < MTOK; t += gridDim.x * 8) {
        const int s = t >> 11, b = c * CH + s; float* xr = a.out + ((size_t)b * SEQ + (t & 2047)) * D; const bf16_t* xb = (const bf16_t*)(a.ws + WS_XB) + ((size_t)b * SEQ + (t & 2047)) * D;
        const int s0 = ts[2 * t], s1 = ts[2 * t + 1]; const float p0 = tp[2 * t], p1 = tp[2 * t + 1];
        const float* g2 = MOD + (size_t)b * 6144 + 5120;
        f32x4 v[4]; float ss = 0.f;
        if (s0 < 32768 && s1 < 32768) {
#pragma unroll
            for (int i = 0; i < 4; ++i) { const int col = lane * 4 + 256 * i;
                const u32x2 pk = *(const u32x2*)(xb + col);
                const f32x4 x = (f32x4){__uint_as_float(pk.x << 16), __uint_as_float(pk.x & 0xffff0000u), __uint_as_float(pk.y << 16), __uint_as_float(pk.y & 0xffff0000u)};
                const f32x4 y0 = ld4bf(YS + (size_t)s0 * D + col), y1 = ld4bf(YS + (size_t)s1 * D + col), g = *(const f32x4*)(g2 + col);
                v[i] = x + g * (y0 * p0 + y1 * p1);
                ss += v[i][0] * v[i][0] + v[i][1] * v[i][1] + v[i][2] * v[i][2] + v[i][3] * v[i][3]; }
        } else {
            const bf16_t* PB = (const bf16_t*)(a.ws + WS_OSCR);
            const bool o0 = s0 >= 32768, o1 = s1 >= 32768;
            const bf16_t* q0 = o0 ? PB + (size_t)(s0 - 32768) * D : YS + (size_t)s0 * D; const bf16_t* q1 = o1 ? PB + (size_t)(s1 - 32768) * D : YS + (size_t)s1 * D;
            const size_t st0 = o0 ? (size_t)2048 * D : 0, st1 = o1 ? (size_t)2048 * D : 0; const float w0 = o0 ? 1.f : 0.f, w1 = o1 ? 1.f : 0.f;
#pragma unroll
            for (int i = 0; i < 4; ++i) { const int col = lane * 4 + 256 * i;
                const u32x2 pk = *(const u32x2*)(xb + col);
                const f32x4 x = (f32x4){__uint_as_float(pk.x << 16), __uint_as_float(pk.x & 0xffff0000u), __uint_as_float(pk.y << 16), __uint_as_float(pk.y & 0xffff0000u)};
                const f32x4 y0 = ld4bf(q0 + col) + ld4bf(q0 + st0 + col) * w0;
                const f32x4 y1 = ld4bf(q1 + col) + ld4bf(q1 + st1 + col) * w1;
                const f32x4 g = *(const f32x4*)(g2 + col);
                v[i] = x + g * (y0 * p0 + y1 * p1);
                ss += v[i][0] * v[i][0] + v[i][1] * v[i][1] + v[i][2] * v[i][2] + v[i][3] * v[i][3]; }
        }
        ss = wave_sum(ss);
        const float rstd = 1.0f / sqrtf(ss * (1.0f / 1024.0f) + EPS);
        float* dst = probe ? (float*)(a.ws + WS_HF) + (size_t)(t & 8191) * D : xr;
#pragma unroll
        for (int i = 0; i < 4; ++i) { const int col = lane * 4 + 256 * i; *(f32x4*)(dst + col) = v[i] * rstd * *(const f32x4*)(fw + col); }
    }
}

#ifndef SITE_MASK
#define SITE_MASK 0xFFFFFFFFu
#endif
constexpr int STEPS_L0 = 9, STEPS_L1 = 11, NSTEPS = 1 + 2 + NCH * (STEPS_L0 + STEPS_L1) + 5;

__global__ void __launch_bounds__(NTHREADS, 2) hybrid_fwd(Args a) {
    extern __shared__ __attribute__((aligned(16))) unsigned char lds[];
    LAS unsigned char* ldsl = (LAS unsigned char*)lds;
    const int lo = a.ph_lo, hi = a.ph_hi;
    if (threadIdx.x < 16) ((LAS unsigned*)(ldsl + MISC_OFF))[threadIdx.x] = 0u;
    __syncthreads();
    XcdBarrier bar; bar.bar = (unsigned*)(a.ws + WS_CTL); bar.x = 0; bar.st = (volatile LAS unsigned*)(ldsl + MISC_OFF);
    if (hi - lo > 1) bar = xcd_barrier_post((unsigned*)(a.ws + WS_CTL), (volatile LAS unsigned*)(ldsl + MISC_OFF));
    int step = 0;
#define RUN(site, ...) do { if (step >= lo && step < hi) { if constexpr ((SITE_MASK >> (site)) & 1) { for (int rep_ = 0; rep_ < (((site) == REP_SITE) ? REP_N + 1 : 1); ++rep_) { __VA_ARGS__; } } if (step + 1 < hi) { for (int rb_ = 0; rb_ < BAR_N; ++rb_) xcd_barrier(bar); } } ++step; } while (0)
    const int G = gridDim.x, bx = blockIdx.x;
    unsigned char* ws = a.ws;

    RUN(0, phase_prologue(a, ldsl));

    for (int l = 0; l < 2; ++l) {
        for (int c = 0; c < NCH; ++c) {
            const int latonly = 1;
            const int nMres = CH * 8;
            if (c == 0) RUN(1, phase_norm<false>(a, l, c, 0, false, ldsl));
            RUN(2, { pg8::SchedPlain S{(const char*)(ws + WS_U), (const char*)(ws + WS_WIN) + (size_t)l * DIN * D * 2, (size_t)256 * D * 2, (size_t)256 * D * 2, CTILES, DIN / 256, G, bx, 0};
                  pg8::EpiBf16 E{(bf16_t*)(ws + WS_Z), ZLD, nullptr, ZC_GA / 256, (bf16_t*)(ws + WS_GZT), (const float*)(ws + WS_ROPE), ZC_Q / 256, ZC_V / 256, ZC_AC / 256, ZC_RG / 256, ZC_RG / 256, ZC_RX / 256};
                  pg8::gemm_phase<false>(ldsl, (D) * 2, (D) * 2, (D) / 64, S, E); });
            RUN(3, phase_elem(a, l, rep_ != 0));
            RUN(4, { pg8::SchedGate S{(const char*)(ws + WS_XC), (const char*)(ws + WS_WG) + (size_t)l * 8 * 256 * 256 * 2, G, bx};
                  pg8::EpiGate E{(bf16_t*)(ws + WS_G), (const bf16_t*)(ws + WS_XC), (const float*)(ws + WS_GB) + l * 2048, (const float*)(ws + WS_COEF) + l * 1024};
                  pg8::gemm_phase<false>(ldsl, (1024) * 2, (256) * 2, (256) / 64, S, E);
                  __syncthreads(); phase_attn(a, l, lds); });
            RUN(5, phase_scan(a, l, ldsl));
            RUN(7, { pg8::SchedMerge S{(const char*)(ws + WS_YCAT), (const char*)(ws + WS_WBR) + (size_t)l * D * 1536 * 2, nMres, G, bx, latonly};
                  pg8::EpiMerge E{(const bf16_t*)(ws + WS_GZT), (bf16_t*)(ws + WS_M)};
                  pg8::gemm_phase<false>(ldsl, (1536) * 2, (1536) * 2, (512) / 64, S, E);
                  if (l == 0) copy_ctx_side(a, c); });
            RUN(8, { pg8::SchedPlain S{(const char*)(ws + WS_M), (const char*)(ws + WS_WOUT) + (size_t)l * D * D * 2, (size_t)256 * D * 2, (size_t)256 * D * 2, nMres, 4, G, bx, latonly};
                  const float* gp = rep_ == 0 ? (const float*)(ws + WS_MOD) + (size_t)l * 33 * 6144 + 2048 : (const float*)(ws + WS_CTL + CTL_ZEROG);
                  if (l == 0 && rep_ == 0) { pg8::EpiRes<true> E{(const void*)a.in[I_X], (const void*)a.in[I_CTX], (bf16_t*)(ws + WS_XB), (bf16_t*)(ws + WS_CX), gp, c, 0};
                      pg8::gemm_phase<false>(ldsl, (D) * 2, (D) * 2, (D) / 64, S, E); }
                  else { pg8::EpiRes<false> E{(const void*)(ws + WS_XB), (const void*)(ws + WS_CX), (bf16_t*)(ws + WS_XB), (bf16_t*)(ws + WS_CX), gp, c, 0};
                      pg8::gemm_phase<false>(ldsl, (D) * 2, (D) * 2, (D) / 64, S, E); } });
            if (l == 0) {
                RUN(9, phase_norm<false>(a, l, c, 1, true, ldsl));
                RUN(10, { constexpr int EB = DENSE_F8 ? 1 : 2;
                      pg8::SchedPlain S{(const char*)(ws + WS_U), (const char*)(ws + WS_F13), (size_t)256 * D * EB, (size_t)256 * D * EB, CH * 8, DIN / 256, G, bx, 1};
                      pg8::EpiSwiglu<DENSE_F8> E{(bf16_t*)(ws + WS_ACT)};
                      pg8::gemm_phase<DENSE_F8>(ldsl, D * EB, D * EB, D * EB / 128, S, E); });
                RUN(11, { constexpr int EB = DENSE_F8 ? 1 : 2;
                      pg8::SchedPlain S{(const char*)(ws + WS_ACT), (const char*)(ws + WS_F2), (size_t)256 * FF * EB, (size_t)256 * FF * EB, CH * 8, 4, G, bx, 1};
                      pg8::EpiRes<false> E{(const void*)(ws + WS_XB), (const void*)(ws + WS_CX), (bf16_t*)(ws + WS_XB), (bf16_t*)(ws + WS_CX), rep_ == 0 ? (const float*)(ws + WS_MOD) + (size_t)l * 33 * 6144 + 5120 : (const float*)(ws + WS_CTL + CTL_ZEROG), c, 0};
                      pg8::gemm_phase<DENSE_F8>(ldsl, FF * EB, FF * EB, FF * EB / 128, S, E);
                      if (c + 1 < NCH) { __syncthreads(); phase_norm<false>(a, l, c + 1, 0, false, ldsl); } });
            } else {
                RUN(12, phase_norm<true>(a, l, c, 1, true, ldsl, rep_ != 0));
                RUN(13, phase_scatter(a, c));
                RUN(14, { pg8::SchedMoe S; S.A = (const char*)(ws + WS_HS); S.B = (const char*)(ws + WS_M13); S.a_ts = (size_t)256 * D; S.b_ts = (size_t)256 * D; S.e_stride = (size_t)DIN * D;
                      S.nN = DIN / 256; S.G = G; S.c = bx; moe_pad_end((const int*)(ws + WS_CTL + CTL_CNT) + c * 32, S.pe); S.nM = S.pe[7] >> 8;
                      pg8::EpiSwiglu<true> E{(bf16_t*)(ws + WS_ACT)};
                      pg8::gemm_phase<true>(ldsl, D, D, D / 128, S, E); });
                RUN(15, { pg8::SchedMoe S; S.A = (const char*)(ws + WS_ACT); S.B = (const char*)(ws + WS_M2); S.a_ts = (size_t)256 * FF; S.b_ts = (size_t)256 * FF; S.e_stride = (size_t)D * FF;
                      S.nN = 4; S.G = G; S.c = bx; moe_pad_end((const int*)(ws + WS_CTL + CTL_CNT) + c * 32, S.pe); const int nMt = S.pe[7] >> 8; S.nM = nMt < 128 ? nMt : 128;
                      pg8::EpiBf16 E{(bf16_t*)(ws + WS_YS), D, nullptr, 1 << 30, nullptr, nullptr, 1 << 30, 1 << 30, 1 << 30, 1 << 30, 1 << 30, 1 << 30};
                      pg8::gemm_phase<true>(ldsl, FF, FF, FF / 128, S, E);
                      if (nMt > 128) {
                          __syncthreads();
                          pg8::SchedMoeSplit S2; S2.A = S.A; S2.B = S.B; S2.a_ts = S.a_ts; S2.b_ts = S.b_ts; S2.e_stride = S.e_stride; S2.nR = nMt - 128; S2.G = G; S2.c = bx;
                          _Pragma("unroll") for (int j = 0; j < 8; ++j) S2.pe[j] = S.pe[j];
                          pg8::EpiBf16 E2{(bf16_t*)(ws + WS_OSCR), D, nullptr, 1 << 30, nullptr, nullptr, 1 << 30, 1 << 30, 1 << 30, 1 << 30, 1 << 30, 1 << 30};
                          pg8::gemm_phase<true>(ldsl, FF, FF, 14, S2, E2); } });
                RUN(16, { phase_combine(a, c, rep_ != 0); if (c + 1 < NCH) phase_norm<false>(a, l, c + 1, 0, false, ldsl); });
            }
        }
        if (l == 0) {
            RUN(17, { pg8::SchedMerge S{(const char*)(ws + WS_YCATC), (const char*)(ws + WS_WBR), NB, G, bx, 0};
                      pg8::EpiMerge E{(const bf16_t*)(ws + WS_ZGC), (bf16_t*)(ws + WS_M)};
                      pg8::gemm_phase<false>(ldsl, (1536) * 2, (1536) * 2, (512) / 64, S, E); });
            RUN(18, { pg8::SchedPlain S{(const char*)(ws + WS_M), (const char*)(ws + WS_WOUT), (size_t)256 * D * 2, (size_t)256 * D * 2, NB, 4, G, bx, 0};
                      pg8::EpiRes<true> E{(const void*)a.in[I_X], (const void*)a.in[I_CTX], (bf16_t*)(ws + WS_XB), (bf16_t*)(ws + WS_CX), (const float*)(ws + WS_MOD) + 2048, 0, 1};
                      pg8::gemm_phase<false>(ldsl, (D) * 2, (D) * 2, (D) / 64, S, E); });
            RUN(19, phase_norm<false>(a, 0, 0, 1, false, ldsl, false, true));
            RUN(20, { constexpr int EB = DENSE_F8 ? 1 : 2;
                      pg8::SchedPlain S{(const char*)(ws + WS_U), (const char*)(ws + WS_F13), (size_t)256 * D * EB, (size_t)256 * D * EB, NB, DIN / 256, G, bx, 0};
                      pg8::EpiSwiglu<DENSE_F8> E{(bf16_t*)(ws + WS_ACT)};
                      pg8::gemm_phase<DENSE_F8>(ldsl, D * EB, D * EB, D * EB / 128, S, E); });
            RUN(21, { constexpr int EB = DENSE_F8 ? 1 : 2;
                      pg8::SchedPlain S{(const char*)(ws + WS_ACT), (const char*)(ws + WS_F2), (size_t)256 * FF * EB, (size_t)256 * FF * EB, NB, 4, G, bx, 0};
                      pg8::EpiRes<false> E{(const void*)(ws + WS_XB), (const void*)(ws + WS_CX), (bf16_t*)(ws + WS_XB), (bf16_t*)(ws + WS_CX), (const float*)(ws + WS_MOD) + 5120, 0, 1};
                      pg8::gemm_phase<DENSE_F8>(ldsl, FF * EB, FF * EB, FF * EB / 128, S, E); });
        }
    }
#undef RUN
}

#ifndef MK_N_LAUNCHES
#define MK_N_LAUNCHES 1
#endif
extern "C" void kernel_launch(void* const* d_in, const int* in_sizes, int n_in, void* d_out, int out_size, void* d_ws, size_t ws_size, hipStream_t stream) {
    static int grid = 0;
    if (grid == 0) {
        if (n_in != 27 || out_size != NB * SEQ * D || ws_size < WS_END) { fprintf(stderr, "kernel_launch: unexpected shapes: n_in %d out %d ws %zu (need %zu)\n", n_in, out_size, ws_size, (size_t)WS_END); grid = -1; return; }
        int dev = 0, cus = 0, per_cu = 0;
        if (hipGetDevice(&dev) != hipSuccess || hipDeviceGetAttribute(&cus, hipDeviceAttributeMultiprocessorCount, dev) != hipSuccess) { grid = -1; return; }
        if (hipFuncSetAttribute((const void*)hybrid_fwd, hipFuncAttributeMaxDynamicSharedMemorySize, LDS_BYTES) != hipSuccess) { fprintf(stderr, "kernel_launch: hipFuncSetAttribute failed\n"); grid = -1; return; }
        if (hipOccupancyMaxActiveBlocksPerMultiprocessor(&per_cu, (const void*)hybrid_fwd, NTHREADS, LDS_BYTES) != hipSuccess || per_cu < 1) { fprintf(stderr, "kernel_launch: occupancy query says %d\n", per_cu); }
        (void)hipGetLastError();
        grid = cus;
    }
    if (grid < 0) return;
    if (hipMemsetAsync((char*)d_ws + WS_CTL, 0, CTL_BYTES, stream) != hipSuccess) return;
    Args a{};
    for (int i = 0; i < 27; ++i) a.in[i] = (const float*)d_in[i];
    a.out = (float*)d_out; a.ws = (unsigned char*)d_ws;
#if MK_N_LAUNCHES == 1
    a.ph_lo = 0; a.ph_hi = NSTEPS;
    hipLaunchKernelGGL(hybrid_fwd, dim3(grid), dim3(NTHREADS), LDS_BYTES, stream, a);
#else
    for (int s = 0; s < NSTEPS; ++s) { a.ph_lo = s; a.ph_hi = s + 1; hipLaunchKernelGGL(hybrid_fwd, dim3(grid), dim3(NTHREADS), LDS_BYTES, stream, a); }
#endif
}
```

```cpp
#include <hip/hip_runtime.h>
#include <cstdio>
#include <cstdint>

#define LAS __attribute__((address_space(3)))
typedef unsigned short bf16_t;
typedef short bf16x8 __attribute__((ext_vector_type(8)));
typedef short s16x4 __attribute__((ext_vector_type(4)));
typedef float f32x4 __attribute__((ext_vector_type(4)));
typedef float f32x2 __attribute__((ext_vector_type(2)));
typedef float f32x16 __attribute__((ext_vector_type(16)));
typedef unsigned u32x4 __attribute__((ext_vector_type(4)));
typedef unsigned u32x2 __attribute__((ext_vector_type(2)));

constexpr int D = 1024, NB = 32, SEQ = 2048, CTXL = 256, TOK = SEQ + CTXL, DIN = 7168, FF = 3584, NEXP = 8;
constexpr int ZLD = 4096 + 64;
constexpr int CH = 8, NCH = NB / CH, CROWS = CH * TOK, CTILES = CROWS / 256;
constexpr int ZC_AB = 0, ZC_AC = 512, ZC_AX = 1024, ZC_RG = 1536, ZC_RX = 2048, ZC_Q = 2560, ZC_K = 3072, ZC_V = 3584, ZC_GA = 4096;
constexpr int MTOK = CH * SEQ;
constexpr int MSLOT_MAX = 2 * MTOK + NEXP * 256;
constexpr float EPS = 1e-6f;
constexpr int NTHREADS = 512;
constexpr int LDS_BYTES = 147456, MISC_OFF = 147200;

constexpr bool DENSE_F8 = true;
constexpr int REP_SITE = -1, REP_N = 1, BAR_N = 1;
constexpr size_t al256(size_t x) { return (x + 255) & ~(size_t)255; }
constexpr size_t WS_CTL = 0;
constexpr size_t CTL_BYTES = 65536 + (REP_SITE >= 0 ? 1048576 : 0);
constexpr size_t CTL_ZEROG = 65536;
constexpr size_t CTL_PANEL = 32768;
constexpr size_t CTL_CNT = 16384;
constexpr size_t WS_MOD = WS_CTL + CTL_BYTES;
constexpr size_t WS_ROPE = WS_MOD + al256((size_t)2 * 33 * 6144 * 4);
constexpr size_t WS_GB = WS_ROPE + (size_t)2 * 2048 * 32 * 4;
constexpr size_t WS_COEF = WS_GB + (size_t)2 * 2048 * 4;
constexpr size_t WS_LAM = WS_COEF + (size_t)2 * 1024 * 4;
constexpr size_t WS_WIN = WS_LAM + 256;
constexpr size_t WS_WBR = WS_WIN + (size_t)2 * DIN * D * 2;
constexpr size_t WS_WOUT = WS_WBR + (size_t)2 * D * 1536 * 2;
constexpr size_t WS_WG = WS_WOUT + (size_t)2 * D * D * 2;
constexpr size_t WS_F13 = WS_WG + (size_t)2 * 8 * 256 * 256 * 2;
constexpr size_t WS_F2 = WS_F13 + (size_t)DIN * D * 2;
constexpr size_t WS_M13 = WS_F2 + (size_t)D * FF * 2;
constexpr size_t WS_M2 = WS_M13 + (size_t)NEXP * DIN * D * 2;
constexpr size_t WS_CX = WS_M2 + (size_t)NEXP * D * FF * 2;
constexpr size_t WS_U = WS_CX + (size_t)NB * CTXL * D * 4;
constexpr size_t WS_Z = WS_U + (size_t)CROWS * D * 2;
constexpr size_t WS_GZT = WS_Z + (size_t)CROWS * ZLD * 2;
constexpr size_t WS_XC = WS_GZT + (size_t)CTILES * 12 * 131072;
constexpr size_t WS_G = WS_XC + (size_t)CROWS * 1024 * 2;
constexpr size_t WS_HF = WS_G + (size_t)CROWS * 2048 * 2;
constexpr size_t WS_YCAT = WS_HF + (size_t)CROWS * 512 * 4;
constexpr size_t WS_M = WS_YCAT + (size_t)CROWS * 1536 * 2;
constexpr size_t WS_OSCR = WS_M + (size_t)CROWS * D * 2;
constexpr size_t WS_TOKE = WS_OSCR + (size_t)256 * 131072;
constexpr size_t WS_TOKP = WS_TOKE + (size_t)MTOK * 2 * 4;
constexpr size_t WS_TOKS = WS_TOKP + (size_t)MTOK * 2 * 4;
constexpr size_t WS_TSLOT = WS_TOKS + (size_t)MTOK * 2 * 4;
constexpr size_t WS_YCATC = WS_TSLOT + (size_t)MTOK * 2 * 4;
constexpr size_t WS_ZGC = WS_YCATC + (size_t)NB * CTXL * 1536 * 2;
constexpr size_t WS_XB = WS_ZGC + (size_t)NB * CTXL * 3072 * 2;
constexpr size_t WS_END = WS_XB + (size_t)NB * SEQ * D * 2;
constexpr size_t WS_ACT = WS_Z;
constexpr size_t WS_YS = WS_XC;
constexpr size_t WS_HS = WS_YCAT;
static_assert((size_t)MSLOT_MAX * FF * 2 <= WS_XC - WS_Z, "ACT fits Z + GZT");
static_assert((size_t)MSLOT_MAX * D * 4 <= WS_YCAT - WS_XC, "YS fits R1");
static_assert((size_t)MSLOT_MAX * D * 2 <= WS_OSCR - WS_YCAT, "HS fits R2");

__device__ __forceinline__ float bf2f(bf16_t b) { return __uint_as_float(((unsigned)b) << 16); }
__device__ __forceinline__ unsigned cvt_pk_bf16(float lo, float hi) { unsigned r; asm volatile("v_cvt_pk_bf16_f32 %0, %1, %2" : "=v"(r) : "v"(lo), "v"(hi)); return r; }
__device__ __forceinline__ bf16_t f2bf(float f) { return (bf16_t)(cvt_pk_bf16(f, 0.f) & 0xffffu); }
__device__ __forceinline__ void unpack8(const u32x4 w, float (&f)[8]) {
#pragma unroll
    for (int i = 0; i < 4; ++i) { f[2 * i] = __uint_as_float(w[i] << 16); f[2 * i + 1] = __uint_as_float(w[i] & 0xffff0000u); }
}
__device__ __forceinline__ u32x4 pack8(const float (&f)[8]) {
    u32x4 w; w.x = cvt_pk_bf16(f[0], f[1]); w.y = cvt_pk_bf16(f[2], f[3]); w.z = cvt_pk_bf16(f[4], f[5]); w.w = cvt_pk_bf16(f[6], f[7]); return w;
}
__device__ __forceinline__ int otid() { int t = threadIdx.x; asm volatile("" : "+v"(t)); return t; }
__device__ __forceinline__ float clamp448(float x) { return __builtin_amdgcn_fmed3f(x, -448.0f, 448.0f); }
__device__ __forceinline__ unsigned pack4_fp8(float a, float b, float c, float d) {
    int p = __builtin_amdgcn_cvt_pk_fp8_f32(clamp448(a), clamp448(b), 0, false); p = __builtin_amdgcn_cvt_pk_fp8_f32(clamp448(c), clamp448(d), p, true); return (unsigned)p; }
__device__ __forceinline__ unsigned pack4_lowbytes(float a, float b, float c, float d) {
    const unsigned lo = __builtin_amdgcn_perm(__float_as_uint(b), __float_as_uint(a), 0x0c0c0400u), hi = __builtin_amdgcn_perm(__float_as_uint(d), __float_as_uint(c), 0x0c0c0400u);
    return __builtin_amdgcn_perm(hi, lo, 0x05040100u); }
__device__ __forceinline__ float frcp(float x) { return __builtin_amdgcn_rcpf(x); }
__device__ __forceinline__ float sigmoidf_(float x) { return frcp(1.0f + __expf(-x)); }
__device__ __forceinline__ float wave_sum(float v) {
#pragma unroll
    for (int o = 32; o >= 1; o >>= 1) v += __shfl_xor(v, o);
    return v;
}

#define XB_TMO      128
#define XB_XCNT(j)  (256  + 64 * (j))
#define XB_XSUB(j)  (1280 + 64 * (j))
#define XB_XGEN(j)  (2304 + 64 * (j))
#define XB_TOP      3328
#define XB_TOPGEN   3392
#define XCD_BAR_WORDS 3456
#define XB_SPIN_CAP (1u << 22)

__device__ __forceinline__ unsigned xb_ld(unsigned* p)              { return __hip_atomic_load(p, __ATOMIC_RELAXED, __HIP_MEMORY_SCOPE_AGENT); }
__device__ __forceinline__ unsigned xb_add(unsigned* p, unsigned v) { return __hip_atomic_fetch_add(p, v, __ATOMIC_RELAXED, __HIP_MEMORY_SCOPE_AGENT); }
__device__ __forceinline__ unsigned xb_xcc_id() { return (unsigned)__builtin_amdgcn_s_getreg((3 << 11) | 20) & 0xFu; }
#define XB_SPIN(cond, bar) do { unsigned _sp = 0; while (cond) { __builtin_amdgcn_s_sleep(1); \
    if ((++_sp & 255u) == 0u) { if (xb_ld(&(bar)[XB_TMO])) break; if (_sp > XB_SPIN_CAP) { atomicAdd(&(bar)[XB_TMO], 1u); break; } } } } while (0)

struct XcdBarrier { unsigned* bar; unsigned x; volatile LAS unsigned* st; };

__device__ __forceinline__ XcdBarrier xcd_barrier_post(unsigned* bar, volatile LAS unsigned* st) {
    XcdBarrier b; b.bar = bar; b.x = xb_xcc_id(); b.st = st;
    if (threadIdx.x == 0) (void)xb_add(&bar[XB_XCNT(b.x)], 1u);
    return b;
}
__device__ __forceinline__ void xcd_barrier_complete(unsigned* bar, unsigned x, unsigned& nloc, unsigned& nx) {
    const unsigned G = gridDim.x * gridDim.y * gridDim.z;
    unsigned sum, cnt, mine, sp = 0u;
    for (;;) {
        sum = 0u; cnt = 0u; mine = 0u;
#pragma unroll
        for (unsigned j = 0; j < 16; ++j) { const unsigned c = xb_ld(&bar[XB_XCNT(j)]); sum += c; cnt += (c > 0u) ? 1u : 0u; mine = (j == x) ? c : mine; }
        if (sum == G) break;
        __builtin_amdgcn_s_sleep(1);
        if ((++sp & 255u) == 0u) { if (xb_ld(&bar[XB_TMO])) break; if (sp > XB_SPIN_CAP) { atomicAdd(&bar[XB_TMO], 1u); break; } }
    }
    nloc = mine > 0u ? mine : 1u; nx = cnt > 0u ? cnt : 1u;
}
__device__ __forceinline__ void xcd_barrier(const XcdBarrier& b) {
    asm volatile("s_waitcnt vmcnt(0)" ::: "memory");
    __syncthreads();
    if (threadIdx.x == 0) {
        unsigned* bar = b.bar;
        __builtin_amdgcn_s_waitcnt(0);
        unsigned nloc = b.st[0], nx = b.st[1];
        if (nloc == 0u) { xcd_barrier_complete(bar, b.x, nloc, nx); b.st[0] = nloc; b.st[1] = nx; }
        const unsigned old = xb_add(&bar[XB_XSUB(b.x)], 1u);
        const unsigned gen = old / nloc;
        if (old + 1u == (gen + 1u) * nloc) {
            __builtin_amdgcn_fence(__ATOMIC_RELEASE, "agent");
            asm volatile("s_waitcnt vmcnt(0)" ::: "memory");
            const unsigned og = xb_add(&bar[XB_TOP], 1u);
            const unsigned tg = og / nx;
            if (og + 1u == (tg + 1u) * nx) xb_add(&bar[XB_TOPGEN], 1u);
            else XB_SPIN(xb_ld(&bar[XB_TOPGEN]) == tg, bar);
            __builtin_amdgcn_fence(__ATOMIC_ACQUIRE, "agent");
            xb_add(&bar[XB_XGEN(b.x)], 1u);
            asm volatile("s_waitcnt vmcnt(0)" ::: "memory");
        } else {
            XB_SPIN(xb_ld(&bar[XB_XGEN(b.x)]) == gen, bar);
            __builtin_amdgcn_fence(__ATOMIC_ACQUIRE, "agent");
            asm volatile("s_waitcnt vmcnt(0)" ::: "memory");
        }
    }
    __syncthreads();
}

namespace pg8 {
constexpr int BM = 256, BK = 64, HALF = 128, HTB = HALF * BK * 2, STAGE_BYTES = 8 * HTB, NXCD = 8, WGM = 8;
__device__ __forceinline__ int lds_byte(int r, int c) { const int st = (r >> 4) * 2 + (c >> 5), rr = r & 15, cc = c & 31, ob = rr * 64 + cc * 2; return st * 1024 + (ob ^ (((ob >> 9) & 1) << 5)); }
__device__ __forceinline__ void stage_rc(int b, int& R, int& C) { const int st = b / 1024, sb = b % 1024, swz = sb ^ (((sb >> 9) & 1) << 5); R = (st >> 1) * 16 + swz / 64; C = (st & 1) * 32 + (swz % 64) / 2; }
__device__ __forceinline__ int perm32(int rho) { const int n = rho >> 4, i = rho & 15; return 8 * (i >> 2) + 4 * n + (i & 3); }

struct Unit { const char* A; const char* B; int pm, pn, seg, aux; };

__device__ __forceinline__ bool tile_of(long L, int nM, int nN, int& pm, int& pn) {
    const int nwg = nM * nN; if (L >= nwg) return false;
    int wgid = (int)L; { const int q = nwg / NXCD, r = nwg % NXCD, xcd = wgid % NXCD, off = wgid / NXCD; wgid = (xcd < r ? xcd * (q + 1) : r * (q + 1) + (xcd - r) * q) + off; }
    const int nig = WGM * nN, gid = wgid / nig, fm = gid * WGM, gsz = (nM - fm) < WGM ? (nM - fm) : WGM;
    pm = fm + ((wgid % nig) % gsz); pn = (wgid % nig) / gsz; return true;
}

template <bool F8, class Epi, class Sched>
__device__ __forceinline__ void gemm_phase(LAS unsigned char* lds, const int lda, const int ldb, const int nt, const Sched& S, const Epi& E) {
    const int tid = otid(), wid = __builtin_amdgcn_readfirstlane(tid >> 6), lane = tid & 63, wr = wid >> 2, wc = wid & 3, fr = lane & 15, fq = lane >> 4;
    unsigned voffA[2], voffB[2];
#pragma unroll
    for (int i = 0; i < 2; ++i) { int R, C; stage_rc(tid * 16 + i * 8192, R, C); const int Rb = Epi::PERM ? ((R & ~31) + perm32(R & 31)) : R;
        voffA[i] = (unsigned)(R * lda + C * 2); voffB[i] = (unsigned)(Rb * ldb + C * 2); }
    const size_t kstep = (size_t)(BK * 2);
    const size_t hstepA = (size_t)HALF * lda, hstepB = (size_t)HALF * ldb;
    const unsigned ldsw = (unsigned)wid * 1024u;
    const int aoff = lds_byte(wr * 64 + fr, fq * 8), boff = lds_byte(wc * 32 + fr, fq * 8);
#define PG8_SA(b, h) (((b) * 2 + (h)) * HTB)
#define PG8_SB(b, h) ((4 + (b) * 2 + (h)) * HTB)
#define PG8_STAGE(bufoff, gbase, voff) do { _Pragma("unroll") for (int _i = 0; _i < 2; ++_i) \
        __builtin_amdgcn_global_load_lds((const unsigned*)((const char*)(gbase) + (voff)[_i]), (LAS unsigned*)(lds + (bufoff) + ldsw + _i * 8192), 16, 0, 0); } while (0)
#define PG8_LDA(dst, b, h) do { _Pragma("unroll") for (int m = 0; m < 4; ++m) { const i32x4v lo_ = *(const LAS i32x4v*)(lds + PG8_SA(b, h) + aoff + m * 2048), hi_ = *(const LAS i32x4v*)(lds + PG8_SA(b, h) + aoff + m * 2048 + 1024); \
        dst[m] = __builtin_shufflevector(lo_, hi_, 0, 1, 2, 3, 4, 5, 6, 7); } } while (0)
#define PG8_LDB(dst, b, h) do { _Pragma("unroll") for (int n = 0; n < 2; ++n) { const i32x4v lo_ = *(const LAS i32x4v*)(lds + PG8_SB(b, h) + boff + n * 2048), hi_ = *(const LAS i32x4v*)(lds + PG8_SB(b, h) + boff + n * 2048 + 1024); \
        dst[n] = __builtin_shufflevector(lo_, hi_, 0, 1, 2, 3, 4, 5, 6, 7); } } while (0)
#define PG8_MMA(ai, bj, At, Bt) do { __builtin_amdgcn_s_setprio(1); _Pragma("unroll") for (int m = 0; m < 4; ++m) _Pragma("unroll") for (int n = 0; n < 2; ++n) { \
        if constexpr (F8) asm volatile("v_mfma_scale_f32_16x16x128_f8f6f4 %0, %1, %2, %0, %3, %4 op_sel_hi:[0,0,0]" : "+v"(acc[ai][bj][m][n]) : "v"(Bt[n]), "v"(At[m]), "v"(scl_w), "v"(scl_a)); \
        else { acc[ai][bj][m][n] = __builtin_amdgcn_mfma_f32_16x16x32_bf16((bf16x8)__builtin_shufflevector(Bt[n], Bt[n], 0, 1, 2, 3), (bf16x8)__builtin_shufflevector(At[m], At[m], 0, 1, 2, 3), acc[ai][bj][m][n], 0, 0, 0); \
               acc[ai][bj][m][n] = __builtin_amdgcn_mfma_f32_16x16x32_bf16((bf16x8)__builtin_shufflevector(Bt[n], Bt[n], 4, 5, 6, 7), (bf16x8)__builtin_shufflevector(At[m], At[m], 4, 5, 6, 7), acc[ai][bj][m][n], 0, 0, 0); } } \
        __builtin_amdgcn_s_setprio(0); } while (0)
#define PG8_WAIT_V(n) asm volatile("s_waitcnt vmcnt(" #n ")" ::: "memory")
#define PG8_WAIT_L(n) asm volatile("s_waitcnt lgkmcnt(" #n ")" ::: "memory")
#define PG8_BAR __builtin_amdgcn_s_barrier()
#define PG8_SCHED __builtin_amdgcn_sched_barrier(0)
    Unit cur, nxt; int ui = 0;
    if (!S.next(0, cur)) return;
    f32x4 acc[2][2][4][2];
#pragma unroll
    for (int a = 0; a < 2; ++a)
#pragma unroll
        for (int b = 0; b < 2; ++b)
#pragma unroll
            for (int m = 0; m < 4; ++m)
#pragma unroll
                for (int n = 0; n < 2; ++n) acc[a][b][m][n] = (f32x4){0.f, 0.f, 0.f, 0.f};
    typedef int i32x4v __attribute__((ext_vector_type(4))); typedef int i32x8v __attribute__((ext_vector_type(8)));
    i32x8v At[4], B0[2], B1[2];
    const int scl_w = 0x79797979, scl_a = 0x7f7f7f7f;
    const char* cA = cur.A; const char* cB = cur.B;
    PG8_STAGE(PG8_SB(0, 0), cB, voffB); PG8_STAGE(PG8_SA(0, 0), cA, voffA); PG8_STAGE(PG8_SB(0, 1), cB + hstepB, voffB); PG8_STAGE(PG8_SA(0, 1), cA + hstepA, voffA);
    if (wr == 1) PG8_BAR;
    PG8_WAIT_V(4); PG8_BAR;
    PG8_STAGE(PG8_SB(1, 0), cB + kstep, voffB); PG8_STAGE(PG8_SA(1, 0), cA + kstep, voffA); PG8_STAGE(PG8_SB(1, 1), cB + hstepB + kstep, voffB);
    PG8_WAIT_V(6); PG8_BAR;
    for (;;) {
        const bool has_next = S.next(ui + 1, nxt);
        const char* nA = has_next ? nxt.A : cA; const char* nB = has_next ? nxt.B : cB;
#pragma nounroll
        for (int t = 0; t < nt; t += 2) {
            const bool last = (t == nt - 2);
            const char* a1 = cA + (size_t)(t + 1) * kstep;
            const char* a2 = last ? nA : cA + (size_t)(t + 2) * kstep; const char* b2 = last ? nB : cB + (size_t)(t + 2) * kstep;
            const char* a3 = a2 + kstep; const char* b3 = b2 + kstep;
            PG8_LDB(B0, 0, 0); PG8_SCHED; PG8_LDA(At, 0, 0); PG8_STAGE(PG8_SA(1, 1), a1 + hstepA, voffA);
            PG8_WAIT_L(8); PG8_BAR; PG8_WAIT_L(0); PG8_MMA(0, 0, At, B0); PG8_BAR; PG8_SCHED;
            PG8_LDB(B1, 0, 1); PG8_STAGE(PG8_SB(0, 0), b2, voffB);
            PG8_BAR; PG8_WAIT_L(0); PG8_MMA(0, 1, At, B1); PG8_BAR;
            PG8_LDA(At, 0, 1); PG8_STAGE(PG8_SA(0, 0), a2, voffA);
            PG8_BAR; PG8_WAIT_L(0); PG8_MMA(1, 0, At, B0); PG8_BAR; PG8_SCHED;
            PG8_STAGE(PG8_SB(0, 1), b2 + hstepB, voffB);
            PG8_WAIT_V(6); PG8_BAR; PG8_MMA(1, 1, At, B1); PG8_BAR;
            PG8_LDB(B0, 1, 0); PG8_SCHED; PG8_LDA(At, 1, 0); PG8_STAGE(PG8_SA(0, 1), a2 + hstepA, voffA);
            PG8_WAIT_L(8); PG8_BAR; PG8_WAIT_L(0); PG8_MMA(0, 0, At, B0); PG8_BAR; PG8_SCHED;
            PG8_LDB(B1, 1, 1); PG8_STAGE(PG8_SB(1, 0), b3, voffB);
            PG8_BAR; PG8_WAIT_L(0); PG8_MMA(0, 1, At, B1); PG8_BAR;
            PG8_LDA(At, 1, 1); PG8_STAGE(PG8_SA(1, 0), a3, voffA);
            PG8_BAR; PG8_WAIT_L(0); PG8_MMA(1, 0, At, B0); PG8_BAR; PG8_SCHED;
            PG8_STAGE(PG8_SB(1, 1), b3 + hstepB, voffB);
            PG8_WAIT_V(6); PG8_BAR; PG8_MMA(1, 1, At, B1); PG8_BAR;
        }
        if constexpr (F8) asm volatile("s_nop 15\n\ts_nop 15" ::: "memory");
        if constexpr (!Epi::AFTER_DRAIN) { int tz = threadIdx.x; asm volatile("" : "+v"(tz)); const int wid2 = tz >> 6, lane2 = tz & 63; E(acc, cur, wid2 >> 2, wid2 & 3, lane2 & 15, lane2 >> 4); }
        if (!has_next) break;
        if (S.zero_after(cur)) {
#pragma unroll
            for (int a = 0; a < 2; ++a)
#pragma unroll
                for (int b = 0; b < 2; ++b)
#pragma unroll
                    for (int m = 0; m < 4; ++m)
#pragma unroll
                        for (int n = 0; n < 2; ++n) acc[a][b][m][n] = (f32x4){0.f, 0.f, 0.f, 0.f};
        }
        cur = nxt; cA = nA; cB = nB; ++ui;
    }
    PG8_WAIT_V(0);
    if (wr == 0) PG8_BAR;
    PG8_BAR;
    if constexpr (Epi::AFTER_DRAIN) { int tz = threadIdx.x; asm volatile("" : "+v"(tz)); const int wid2 = tz >> 6, lane2 = tz & 63; E(acc, cur, wid2 >> 2, wid2 & 3, lane2 & 15, lane2 >> 4); }
#undef PG8_SA
#undef PG8_SB
#undef PG8_STAGE
#undef PG8_LDA
#undef PG8_LDB
#undef PG8_MMA
#undef PG8_WAIT_V
#undef PG8_WAIT_L
#undef PG8_BAR
#undef PG8_SCHED
}

typedef f32x4 Acc[2][2][4][2];

struct EpiBf16 {
    static constexpr bool PERM = true; static constexpr bool AFTER_DRAIN = false;
    bf16_t* O; int ldc; const float* bias; int sig_from; bf16_t* GT;
    const float* rope; int rope_lo, rope_hi;
    int prod_lo, prod_hi;
    int gelu_lo, gelu_hi;
    bf16_t* RGP;
    __device__ __forceinline__ void operator()(Acc& acc, const Unit& u, int wr, int wc, int fr, int fq) const {
        const int row0 = u.pm * BM + wr * 64 + fr, col0 = u.pn * BM + wc * 32 + 8 * fq;
        if (u.pn >= prod_lo && u.pn < prod_hi) {
#pragma unroll
            for (int ai = 0; ai < 2; ++ai)
#pragma unroll
                for (int m = 0; m < 4; ++m) { float v[8];
#pragma unroll
                    for (int n = 0; n < 2; ++n)
#pragma unroll
                        for (int j = 0; j < 4; ++j) v[4 * n + j] = acc[ai][0][m][n][j] * acc[ai][1][m][n][j];
                    *(u32x4*)(O + (size_t)(row0 + ai * HALF + m * 16) * ldc + ZC_AC + (u.pn - prod_lo) * HALF + wc * 32 + 8 * fq) = pack8(v); }
            return;
        }
        if (u.pn >= rope_lo && u.pn < rope_hi) {
            const int t9 = u.pm % 9; const bool isctx = (t9 == 0);
            const int ax = fq >> 1, i0 = (fq & 1) * 8, ncol = u.pn * BM + wc * 64 + ax * 32 + i0;
            const float* RC = rope; const float* RS = rope + 2048 * 32;
#pragma unroll
            for (int ai = 0; ai < 2; ++ai) {
                f32x4 tc[4][4];
#pragma unroll
                for (int m = 0; m < 4; ++m) { const int rt = ai * HALF + wr * 64 + m * 16 + fr, t = isctx ? 0 : (t9 - 1) * 256 + rt;
                    const float* cp = RC + t * 32 + ax * 16 + i0; const float* sp = RS + t * 32 + ax * 16 + i0;
                    tc[m][0] = *(const f32x4*)cp; tc[m][1] = *(const f32x4*)(cp + 4); tc[m][2] = *(const f32x4*)sp; tc[m][3] = *(const f32x4*)(sp + 4); }
#pragma unroll
                for (int m = 0; m < 4; ++m) { const int rt = ai * HALF + wr * 64 + m * 16 + fr;
                    const f32x4 c0 = tc[m][0], c1 = tc[m][1], s0 = tc[m][2], s1 = tc[m][3];
                    float o1[8], o2[8];
#pragma unroll
                    for (int j = 0; j < 4; ++j) {
                        const float ca = isctx ? 1.f : c0[j], sa = isctx ? 0.f : s0[j], cb = isctx ? 1.f : c1[j], sb = isctx ? 0.f : s1[j];
                        const float x1a = acc[ai][0][m][0][j], x2a = acc[ai][1][m][0][j], x1b = acc[ai][0][m][1][j], x2b = acc[ai][1][m][1][j];
                        o1[j] = x1a * ca - x2a * sa; o2[j] = x2a * ca + x1a * sa; o1[4 + j] = x1b * cb - x2b * sb; o2[4 + j] = x2b * cb + x1b * sb; }
                    bf16_t* rp = O + (size_t)(u.pm * BM + rt) * ldc + ncol;
                    *(u32x4*)rp = pack8(o1); *(u32x4*)(rp + 16) = pack8(o2); } }
            return;
        }
        f32x4 bv[2][2];
#pragma unroll
        for (int bj = 0; bj < 2; ++bj)
#pragma unroll
            for (int n = 0; n < 2; ++n) bv[bj][n] = bias ? *(const f32x4*)(bias + col0 + bj * HALF + 4 * n) : (f32x4){0.f, 0.f, 0.f, 0.f};
        if (u.pn >= sig_from) {
            unsigned char* gt = (unsigned char*)GT + (size_t)(u.pm * 12 + (u.pn - sig_from)) * 65536 + (size_t)((((wr * 4 + wc) * 4 + fq) * 16 + fr) * 16);
#pragma unroll
            for (int ai = 0; ai < 2; ++ai)
#pragma unroll
                for (int m = 0; m < 4; ++m) { u32x4 w;
#pragma unroll
                    for (int bj = 0; bj < 2; ++bj) { f32x4 v0 = acc[ai][bj][m][0] + bv[bj][0], v1 = acc[ai][bj][m][1] + bv[bj][1];
#pragma unroll
                        for (int j = 0; j < 4; ++j) { v0[j] = fmaxf(fmaf(sigmoidf_(v0[j]), 255.0f, 8388608.0f), 8388609.0f); v1[j] = fmaxf(fmaf(sigmoidf_(v1[j]), 255.0f, 8388608.0f), 8388609.0f); }
                        w[2 * bj] = pack4_lowbytes(v0[0], v0[1], v0[2], v0[3]); w[2 * bj + 1] = pack4_lowbytes(v1[0], v1[1], v1[2], v1[3]); }
                    *(u32x4*)(gt + (ai * 4 + m) * 8192) = w; }
            return;
        }
#pragma unroll
        for (int ai = 0; ai < 2; ++ai)
#pragma unroll
            for (int m = 0; m < 4; ++m) { bf16_t* rowp = O + (size_t)(row0 + ai * HALF + m * 16) * ldc + col0;
#pragma unroll
                for (int bj = 0; bj < 2; ++bj) { f32x4 v0 = acc[ai][bj][m][0] + bv[bj][0], v1 = acc[ai][bj][m][1] + bv[bj][1];
                    if (u.pn >= gelu_lo && u.pn < gelu_hi) {
#pragma unroll
                        for (int j = 0; j < 4; ++j) { v0[j] = v0[j] * sigmoidf_(1.5957691216057308f * (v0[j] + 0.044715f * v0[j] * v0[j] * v0[j])); v1[j] = v1[j] * sigmoidf_(1.5957691216057308f * (v1[j] + 0.044715f * v1[j] * v1[j] * v1[j])); } }
                    u32x4 w; w.x = cvt_pk_bf16(v0[0], v0[1]); w.y = cvt_pk_bf16(v0[2], v0[3]); w.z = cvt_pk_bf16(v1[0], v1[1]); w.w = cvt_pk_bf16(v1[2], v1[3]);
                    if (RGP != nullptr && u.pn >= gelu_lo && u.pn < gelu_hi) *(u32x4*)(RGP + ((size_t)((((u.pn - gelu_lo) * 256 + bj * HALF + wc * 32) >> 3) + fq) * CROWS + (size_t)(row0 + ai * HALF + m * 16)) * 8) = w;
                    else *(u32x4*)(rowp + bj * HALF) = w; } }
    }
};

template <bool F8OUT>
struct EpiSwiglu {
    static constexpr bool PERM = true; static constexpr bool AFTER_DRAIN = false;
    bf16_t* O;
    __device__ __forceinline__ void operator()(Acc& acc, const Unit& u, int wr, int wc, int fr, int fq) const {
        const int row0 = u.pm * BM + wr * 64 + fr, col0 = u.pn * HALF + wc * 32 + 8 * fq;
#pragma unroll
        for (int ai = 0; ai < 2; ++ai)
#pragma unroll
            for (int m = 0; m < 4; ++m) { bf16_t* rowp = O + (size_t)(row0 + ai * HALF + m * 16) * FF + col0;
                float v[8];
#pragma unroll
                for (int n = 0; n < 2; ++n)
#pragma unroll
                    for (int j = 0; j < 4; ++j) { const float g = acc[ai][0][m][n][j], uu = acc[ai][1][m][n][j]; v[4 * n + j] = g * sigmoidf_(g) * uu; }
                if constexpr (F8OUT) { u32x2 w8; w8.x = pack4_fp8(v[0], v[1], v[2], v[3]); w8.y = pack4_fp8(v[4], v[5], v[6], v[7]);
                    *(u32x2*)((unsigned char*)O + (size_t)(row0 + ai * HALF + m * 16) * FF + col0) = w8; }
                else *(u32x4*)rowp = pack8(v); }
    }
};

struct EpiGate {
    static constexpr bool PERM = true; static constexpr bool AFTER_DRAIN = false;
    bf16_t* G; const bf16_t* XC; const float* bias; const float* coef;
    __device__ __forceinline__ void operator()(Acc& acc, const Unit& u, int wr, int wc, int fr, int fq) const {
        const int dir = u.pn >> 2, q = u.pn & 3, ch0 = 128 * q + wc * 32 + 8 * fq, row0 = u.pm * BM + wr * 64 + fr;
        const float* bp = bias + u.pn * 256 + wc * 32 + 8 * fq;
        float ba[8], bx[8], cf[8];
        { const f32x4 t0 = *(const f32x4*)bp, t1 = *(const f32x4*)(bp + 4), t2 = *(const f32x4*)(bp + 128), t3 = *(const f32x4*)(bp + 132), c0 = *(const f32x4*)(coef + dir * 512 + ch0), c1 = *(const f32x4*)(coef + dir * 512 + ch0 + 4);
#pragma unroll
          for (int j = 0; j < 4; ++j) { ba[j] = t0[j]; ba[4 + j] = t1[j]; bx[j] = t2[j]; bx[4 + j] = t3[j]; cf[j] = c0[j]; cf[4 + j] = c1[j]; } }
        u32x4 xcw[2][4];
#pragma unroll
        for (int ai = 0; ai < 2; ++ai)
#pragma unroll
            for (int m = 0; m < 4; ++m) xcw[ai][m] = *(const u32x4*)(XC + (size_t)(row0 + ai * HALF + m * 16) * 1024 + dir * 512 + ch0);
#pragma unroll
        for (int ai = 0; ai < 2; ++ai)
#pragma unroll
            for (int m = 0; m < 4; ++m) { const size_t row = (size_t)(row0 + ai * HALF + m * 16);
                float xc[8], la[8], bb[8]; unpack8(xcw[ai][m], xc);
#pragma unroll
                for (int n = 0; n < 2; ++n)
#pragma unroll
                    for (int j = 0; j < 4; ++j) { const int e = 4 * n + j;
                        const float rr = sigmoidf_(acc[ai][0][m][n][j] + ba[e]), ii = sigmoidf_(acc[ai][1][m][n][j] + bx[e]);
                        const float l2 = cf[e] * rr, aa = __builtin_amdgcn_exp2f(l2);
                        la[e] = l2; bb[e] = __builtin_amdgcn_sqrtf(fmaxf(1.0f - aa * aa, 0.f)) * (ii * xc[e]); }
                bf16_t* gp = G + ((size_t)(dir * 64 + (ch0 >> 3)) * CROWS + row) * 16;
                u32x4 w0, w1; w0.x = cvt_pk_bf16(la[0], bb[0]); w0.y = cvt_pk_bf16(la[1], bb[1]); w0.z = cvt_pk_bf16(la[2], bb[2]); w0.w = cvt_pk_bf16(la[3], bb[3]);
                w1.x = cvt_pk_bf16(la[4], bb[4]); w1.y = cvt_pk_bf16(la[5], bb[5]); w1.z = cvt_pk_bf16(la[6], bb[6]); w1.w = cvt_pk_bf16(la[7], bb[7]);
                *(u32x4*)gp = w0; *(u32x4*)(gp + 8) = w1; }
    }
};

struct EpiF32 {
    static constexpr bool PERM = false; static constexpr bool AFTER_DRAIN = false;
    float* C;
    __device__ __forceinline__ void operator()(Acc& acc, const Unit& u, int wr, int wc, int fr, int fq) const {
        const int row0 = u.pm * BM + wr * 64 + fr, col0 = u.pn * BM + wc * 32 + 4 * fq;
#pragma unroll
        for (int ai = 0; ai < 2; ++ai)
#pragma unroll
            for (int m = 0; m < 4; ++m) { float* rowp = C + (size_t)(row0 + ai * HALF + m * 16) * D + col0;
#pragma unroll
                for (int bj = 0; bj < 2; ++bj)
#pragma unroll
                    for (int n = 0; n < 2; ++n) *(f32x4*)(rowp + bj * HALF + n * 16) = acc[ai][bj][m][n]; }
    }
};

template <bool IN_F32>
struct EpiRes {
    static constexpr bool PERM = true; static constexpr bool AFTER_DRAIN = false;
    const void* in_lat; const void* in_ctx; bf16_t* out_lat; bf16_t* out_ctx; const float* modg; int c; int cm;
    __device__ __forceinline__ void operator()(Acc& acc, const Unit& u, int wr, int wc, int fr, int fq) const {
        const int s = u.pm / 9, t9 = cm ? 0 : u.pm - 9 * s, b = cm ? u.pm : c * CH + s; const bool isctx = (t9 == 0);
        const size_t base = isctx ? (size_t)b * CTXL * D : ((size_t)b * SEQ + (size_t)(t9 - 1) * 256) * D;
        const void* rin = isctx ? in_ctx : in_lat; bf16_t* rout = (isctx ? out_ctx : out_lat) + base;
        const float* gv = modg + (size_t)(isctx ? 32 : b) * 6144;
        const int rloc = wr * 64 + fr, col0 = u.pn * BM + wc * 32 + 8 * fq;
        f32x4 g4[2][2];
#pragma unroll
        for (int bj = 0; bj < 2; ++bj)
#pragma unroll
            for (int n = 0; n < 2; ++n) g4[bj][n] = *(const f32x4*)(gv + col0 + bj * HALF + n * 4);
#pragma unroll
        for (int ai = 0; ai < 2; ++ai) {
            u32x4 rb[4][2]; f32x4 rf[4][2][2];
#pragma unroll
            for (int m = 0; m < 4; ++m) { const size_t off = (size_t)(rloc + ai * HALF + m * 16) * D + col0;
#pragma unroll
                for (int bj = 0; bj < 2; ++bj) {
                    if constexpr (IN_F32) { rf[m][bj][0] = *(const f32x4*)((const float*)rin + base + off + bj * HALF); rf[m][bj][1] = *(const f32x4*)((const float*)rin + base + off + bj * HALF + 4); }
                    else rb[m][bj] = *(const u32x4*)((const bf16_t*)rin + base + off + bj * HALF); } }
#pragma unroll
            for (int m = 0; m < 4; ++m) { const size_t off = (size_t)(rloc + ai * HALF + m * 16) * D + col0;
#pragma unroll
                for (int bj = 0; bj < 2; ++bj) { float r[8];
                    if constexpr (IN_F32) {
#pragma unroll
                        for (int j = 0; j < 4; ++j) { r[j] = rf[m][bj][0][j]; r[4 + j] = rf[m][bj][1][j]; } }
                    else unpack8(rb[m][bj], r);
#pragma unroll
                    for (int n = 0; n < 2; ++n)
#pragma unroll
                        for (int j = 0; j < 4; ++j) r[4 * n + j] += g4[bj][n][j] * acc[ai][bj][m][n][j];
                    *(u32x4*)(rout + off + bj * HALF) = pack8(r); } }
            asm volatile("" ::: "memory"); }
    }
};

struct EpiResNorm {
    static constexpr bool PERM = true; static constexpr bool AFTER_DRAIN = true;
    const float* in_lat; bf16_t* out_lat; const float* modg; const float* modn; const float* nw; unsigned char* Uo; float* xbuf; unsigned* cnt; unsigned* tmo; unsigned target; int c;
    LAS unsigned char* lds;
    int cm;
    __device__ __forceinline__ void operator()(Acc& acc, const Unit& u, int wr, int wc, int fr, int fq) const {
        const int s = u.pm / 9, t9 = u.pm - 9 * s, b = cm ? u.pm : c * CH + s, mrow = cm ? 32 : b;
        const size_t base = cm ? (size_t)b * CTXL * D : ((size_t)b * SEQ + (size_t)(t9 - 1) * 256) * D;
        const float* gv = modg + (size_t)mrow * 6144;
        const int rloc = wr * 64 + fr, col0 = u.pn * BM + wc * 32 + 8 * fq;
        LAS float* P = (LAS float*)lds; LAS float* S = (LAS float*)(lds + 4096); LAS unsigned* flag = (LAS unsigned*)(lds + 5120);
        f32x4 g4[2][2];
#pragma unroll
        for (int bj = 0; bj < 2; ++bj)
#pragma unroll
            for (int n = 0; n < 2; ++n) g4[bj][n] = *(const f32x4*)(gv + col0 + bj * HALF + n * 4);
#pragma unroll
        for (int aq = 0; aq < 4; ++aq) { const int ai = aq >> 1, m0 = (aq & 1) * 2;
            f32x4 rf[4][2][2];
#pragma unroll
            for (int m = m0; m < m0 + 2; ++m) { const size_t off = (size_t)(rloc + ai * HALF + m * 16) * D + col0;
#pragma unroll
                for (int bj = 0; bj < 2; ++bj) { rf[m][bj][0] = *(const f32x4*)(in_lat + base + off + bj * HALF); rf[m][bj][1] = *(const f32x4*)(in_lat + base + off + bj * HALF + 4); } }
#pragma unroll
            for (int m = m0; m < m0 + 2; ++m) { const size_t off = (size_t)(rloc + ai * HALF + m * 16) * D + col0; float ssq = 0.f;
#pragma unroll
                for (int bj = 0; bj < 2; ++bj) { float r[8];
#pragma unroll
                    for (int n = 0; n < 2; ++n)
#pragma unroll
                        for (int j = 0; j < 4; ++j) { const float x = rf[m][bj][n][j] + g4[bj][n][j] * acc[ai][bj][m][n][j]; r[4 * n + j] = x; acc[ai][bj][m][n][j] = x; ssq += x * x; }
                    *(u32x4*)(out_lat + base + off + bj * HALF) = pack8(r); }
                ssq += __shfl_xor(ssq, 16); ssq += __shfl_xor(ssq, 32);
                if (fq == 0) P[(ai * HALF + wr * 64 + m * 16 + fr) * 4 + wc] = ssq; }
            asm volatile("" ::: "memory"); }
        const float* mr = modn + (size_t)mrow * 6144;
        f32x4 ca[2][2], cb[2][2];
#pragma unroll
        for (int bj = 0; bj < 2; ++bj)
#pragma unroll
            for (int n = 0; n < 2; ++n) { const int col = col0 + bj * HALF + n * 4; ca[bj][n] = *(const f32x4*)(nw + col) * (*(const f32x4*)(mr + 1024 + col) + 1.0f); cb[bj][n] = *(const f32x4*)(mr + col); }
        int tz = threadIdx.x; asm volatile("" : "+v"(tz));
        const int wid = tz >> 6, lane = tz & 63, row = wid * 32 + (lane & 31);
        asm volatile("s_waitcnt lgkmcnt(0)" ::: "memory"); __builtin_amdgcn_s_barrier(); asm volatile("" ::: "memory");
        if (lane < 32) { const float t = (P[row * 4 + 0] + P[row * 4 + 1]) + (P[row * 4 + 2] + P[row * 4 + 3]);
            __hip_atomic_store((unsigned*)xbuf + ((size_t)(u.pm * BM + row) * 4 + u.pn), __float_as_uint(t), __ATOMIC_RELAXED, __HIP_MEMORY_SCOPE_AGENT); }
        asm volatile("s_waitcnt vmcnt(0)" ::: "memory");
        if (lane == 0) __hip_atomic_fetch_add(cnt + 64 * u.pm, 1u, __ATOMIC_RELAXED, __HIP_MEMORY_SCOPE_AGENT);
        if (wid == 0) {
            unsigned sp = 0u, dead = 0u;
            while ((unsigned)__builtin_amdgcn_readfirstlane(__hip_atomic_load(cnt + 64 * u.pm, __ATOMIC_RELAXED, __HIP_MEMORY_SCOPE_AGENT)) < target) {
                __builtin_amdgcn_s_sleep(1);
                if ((++sp & 255u) == 0u) { if (__hip_atomic_load(tmo, __ATOMIC_RELAXED, __HIP_MEMORY_SCOPE_AGENT)) { dead = 1u; break; } if (sp > XB_SPIN_CAP) { atomicAdd(tmo, 1u); dead = 1u; break; } } }
            __builtin_amdgcn_fence(__ATOMIC_ACQUIRE, "agent");
            if (lane == 0) flag[0] = dead;
        }
        asm volatile("s_waitcnt vmcnt(0) lgkmcnt(0)" ::: "memory"); __builtin_amdgcn_s_barrier(); asm volatile("" ::: "memory");
        if (lane < 32) { const unsigned* slot = (const unsigned*)xbuf + (size_t)(u.pm * BM + row) * 4; float ss = 0.f;
#pragma unroll
            for (int t = 0; t < 4; ++t) ss += __uint_as_float(__hip_atomic_load(slot + t, __ATOMIC_RELAXED, __HIP_MEMORY_SCOPE_AGENT));
            S[row] = 1.0f / sqrtf(ss * (1.0f / 1024.0f) + EPS); }
        asm volatile("s_waitcnt vmcnt(0) lgkmcnt(0)" ::: "memory"); __builtin_amdgcn_s_barrier(); asm volatile("" ::: "memory");
#pragma unroll
        for (int ai = 0; ai < 2; ++ai)
#pragma unroll
            for (int m = 0; m < 4; ++m) { const int rl = ai * HALF + wr * 64 + m * 16 + fr; const float rstd = S[rl]; const size_t urow = (size_t)(u.pm * BM + rl);
#pragma unroll
                for (int bj = 0; bj < 2; ++bj) { float h[8];
#pragma unroll
                    for (int n = 0; n < 2; ++n)
#pragma unroll
                        for (int j = 0; j < 4; ++j) h[4 * n + j] = acc[ai][bj][m][n][j] * rstd * ca[bj][n][j] + cb[bj][n][j];
                    if constexpr (DENSE_F8) { u32x2 w8; w8.x = pack4_fp8(h[0], h[1], h[2], h[3]); w8.y = pack4_fp8(h[4], h[5], h[6], h[7]); *(u32x2*)(Uo + urow * D + col0 + bj * HALF) = w8; }
                    else *(u32x4*)((bf16_t*)Uo + urow * D + col0 + bj * HALF) = pack8(h); } }
    }
};

struct EpiResRouter {
    static constexpr bool PERM = true; static constexpr bool AFTER_DRAIN = true;
    const bf16_t* xin; bf16_t* xout; const float* modg; const float* modn; const float* nw; const float* wrt; unsigned char* Uo; float* xbuf; unsigned* cnt; unsigned* tmo; unsigned target; int c;
    int* te; float* tp; int* ts; int* ecnt; LAS unsigned char* lds;
    __device__ __forceinline__ void operator()(Acc& acc, const Unit& u, int wr, int wc, int fr, int fq) const {
        const int s = u.pm / 9, t9 = u.pm - 9 * s, b = c * CH + s;
        const size_t base = ((size_t)b * SEQ + (size_t)(t9 - 1) * 256) * D;
        const float* gv = modg + (size_t)b * 6144; const float* mr = modn + (size_t)b * 6144;
        const int rloc = wr * 64 + fr, col0 = u.pn * BM + wc * 32 + 8 * fq, lcol0 = wc * 32 + 8 * fq;
        LAS float* PA = (LAS float*)lds;
        LAS float* WL = (LAS float*)(lds + 135168);
        LAS float* S = (LAS float*)(lds + 143360);
        LAS float* BL = (LAS float*)(lds + 144384);
        LAS int* hist = (LAS int*)(lds + 144640);
        int tz = threadIdx.x; asm volatile("" : "+v"(tz));
        const int wid = tz >> 6, lane = tz & 63;
        { const int col = tz >> 1, half = tz & 1; const f32x4 w4 = *(const f32x4*)(wrt + (size_t)(u.pn * BM + col) * 8 + half * 4);
#pragma unroll
          for (int j = 0; j < 4; ++j) WL[(half * 4 + j) * 256 + col] = w4[j];
          if (tz < 16) hist[tz] = 0; }

        f32x4 g4[2][2];
#pragma unroll
        for (int bj = 0; bj < 2; ++bj)
#pragma unroll
            for (int n = 0; n < 2; ++n) g4[bj][n] = *(const f32x4*)(gv + col0 + bj * HALF + n * 4);
#pragma unroll
        for (int ai = 0; ai < 2; ++ai) {
            u32x4 rb[4][2];
#pragma unroll
            for (int m = 0; m < 4; ++m)
#pragma unroll
                for (int bj = 0; bj < 2; ++bj) rb[m][bj] = *(const u32x4*)(xin + base + (size_t)(rloc + ai * HALF + m * 16) * D + col0 + bj * HALF);
#pragma unroll
            for (int m = 0; m < 4; ++m) { const size_t off = (size_t)(rloc + ai * HALF + m * 16) * D + col0; float ssq = 0.f;
#pragma unroll
                for (int bj = 0; bj < 2; ++bj) { float r[8]; unpack8(rb[m][bj], r);
#pragma unroll
                    for (int n = 0; n < 2; ++n)
#pragma unroll
                        for (int j = 0; j < 4; ++j) { const float x = r[4 * n + j] + g4[bj][n][j] * acc[ai][bj][m][n][j]; r[4 * n + j] = x; acc[ai][bj][m][n][j] = x; ssq += x * x; }
                    *(u32x4*)(xout + base + off + bj * HALF) = pack8(r); }
                ssq += __shfl_xor(ssq, 16); ssq += __shfl_xor(ssq, 32);
                if (fq == 0) PA[(ai * HALF + wr * 64 + m * 16 + fr) * 4 + wc] = ssq; }
            asm volatile("" ::: "memory"); }
        asm volatile("s_waitcnt lgkmcnt(0)" ::: "memory"); __builtin_amdgcn_s_barrier(); asm volatile("" ::: "memory");
        { float bp[8];
          { const int colb = tz * 2; const f32x2 shb = *(const f32x2*)(mr + colb);
            const f32x4 wb0 = *(const f32x4*)(wrt + (size_t)colb * 8), wb1 = *(const f32x4*)(wrt + (size_t)colb * 8 + 4), wb2 = *(const f32x4*)(wrt + (size_t)colb * 8 + 8), wb3 = *(const f32x4*)(wrt + (size_t)colb * 8 + 12);
#pragma unroll
            for (int j = 0; j < 4; ++j) { bp[j] = shb[0] * wb0[j] + shb[1] * wb2[j]; bp[4 + j] = shb[0] * wb1[j] + shb[1] * wb3[j]; } }
#pragma unroll
          for (int e = 0; e < 8; ++e) { bp[e] = wave_sum(bp[e]); }
          if (lane == 0) {
#pragma unroll
              for (int e = 0; e < 8; ++e) BL[wid * 8 + e] = bp[e]; } }
        const int prow = tz >> 1, eh = tz & 1;
        float ssq_row = (PA[prow * 4 + 0] + PA[prow * 4 + 1]) + (PA[prow * 4 + 2] + PA[prow * 4 + 3]);
        asm volatile("s_waitcnt lgkmcnt(0)" ::: "memory"); __builtin_amdgcn_s_barrier(); asm volatile("" ::: "memory");
        f32x4 ca[2][2], cb[2][2];
#pragma unroll
        for (int bj = 0; bj < 2; ++bj)
#pragma unroll
            for (int n = 0; n < 2; ++n) { const int col = col0 + bj * HALF + n * 4; ca[bj][n] = *(const f32x4*)(nw + col) * (*(const f32x4*)(mr + 1024 + col) + 1.0f); cb[bj][n] = *(const f32x4*)(mr + col); }
        { const int part = wc * 4 + fq;
#pragma unroll
          for (int e = 0; e < 8; ++e) { f32x4 w[2][2];
#pragma unroll
              for (int bj = 0; bj < 2; ++bj)
#pragma unroll
                  for (int n = 0; n < 2; ++n) w[bj][n] = *(LAS const f32x4*)(WL + e * 256 + lcol0 + bj * HALF + n * 4) * ca[bj][n];
#pragma unroll
              for (int ai = 0; ai < 2; ++ai)
#pragma unroll
                  for (int m = 0; m < 4; ++m) { float lg = 0.f;
#pragma unroll
                      for (int bj = 0; bj < 2; ++bj)
#pragma unroll
                          for (int n = 0; n < 2; ++n) { const f32x4 pr = acc[ai][bj][m][n] * w[bj][n]; lg += (pr[0] + pr[1]) + (pr[2] + pr[3]); }
                      const int row = ai * HALF + wr * 64 + m * 16 + fr;
                      PA[row * 132 + e * 16 + ((part + row) & 15)] = lg; } } }
        asm volatile("s_waitcnt lgkmcnt(0)" ::: "memory"); __builtin_amdgcn_s_barrier(); asm volatile("" ::: "memory");
        { float A4[4];
#pragma unroll
          for (int e4 = 0; e4 < 4; ++e4) { LAS const f32x4* q = (LAS const f32x4*)(PA + prow * 132 + (eh * 4 + e4) * 16); const f32x4 q0 = q[0], q1 = q[1], q2 = q[2], q3 = q[3];
              A4[e4] = ((q0[0] + q0[1]) + (q0[2] + q0[3])) + ((q1[0] + q1[1]) + (q1[2] + q1[3])) + ((q2[0] + q2[1]) + (q2[2] + q2[3])) + ((q3[0] + q3[1]) + (q3[2] + q3[3])); }
          unsigned* slot = (unsigned*)xbuf + ((size_t)(u.pm * BM + prow) * 4 + u.pn) * 12;
#pragma unroll
          for (int e4 = 0; e4 < 4; ++e4) __hip_atomic_store(slot + eh * 4 + e4, __float_as_uint(A4[e4]), __ATOMIC_RELAXED, __HIP_MEMORY_SCOPE_AGENT);
          if (eh == 0) __hip_atomic_store(slot + 8, __float_as_uint(ssq_row), __ATOMIC_RELAXED, __HIP_MEMORY_SCOPE_AGENT); }
        asm volatile("s_waitcnt vmcnt(0)" ::: "memory");
        if (lane == 0) __hip_atomic_fetch_add(cnt + 64 * u.pm, 1u, __ATOMIC_RELAXED, __HIP_MEMORY_SCOPE_AGENT);
        if (wid == 0) {
            unsigned sp = 0u;
            while ((unsigned)__builtin_amdgcn_readfirstlane(__hip_atomic_load(cnt + 64 * u.pm, __ATOMIC_RELAXED, __HIP_MEMORY_SCOPE_AGENT)) < target) {
                __builtin_amdgcn_s_sleep(1);
                if ((++sp & 255u) == 0u) { if (__hip_atomic_load(tmo, __ATOMIC_RELAXED, __HIP_MEMORY_SCOPE_AGENT)) break; if (sp > XB_SPIN_CAP) { atomicAdd(tmo, 1u); break; } } }
            __builtin_amdgcn_fence(__ATOMIC_ACQUIRE, "agent");
        }
        asm volatile("s_waitcnt vmcnt(0) lgkmcnt(0)" ::: "memory"); __builtin_amdgcn_s_barrier(); asm volatile("" ::: "memory");
        int e0 = 0, e1 = 0, r0 = 0, r1 = 0; const int frow = u.pn * 64 + tz, tok = s * SEQ + (t9 - 1) * 256 + frow;
        { const unsigned* slp = (const unsigned*)xbuf + (size_t)(u.pm * BM + prow) * 4 * 12; const unsigned* slf = (const unsigned*)xbuf + (size_t)(u.pm * BM + (tz < 64 ? frow : prow)) * 4 * 12;
          float ssp = 0.f, ssf = 0.f, a4[8];
#pragma unroll
          for (int t = 0; t < 4; ++t) ssp += __uint_as_float(__hip_atomic_load(slp + t * 12 + 8, __ATOMIC_RELAXED, __HIP_MEMORY_SCOPE_AGENT));
          if (tz < 64) {
#pragma unroll
              for (int t = 0; t < 4; ++t) ssf += __uint_as_float(__hip_atomic_load(slf + t * 12 + 8, __ATOMIC_RELAXED, __HIP_MEMORY_SCOPE_AGENT));
#pragma unroll
              for (int e = 0; e < 8; ++e) { a4[e] = 0.f;
#pragma unroll
                  for (int t = 0; t < 4; ++t) a4[e] += __uint_as_float(__hip_atomic_load(slf + t * 12 + e, __ATOMIC_RELAXED, __HIP_MEMORY_SCOPE_AGENT)); } }
          if (eh == 0) S[prow] = 1.0f / sqrtf(ssp * (1.0f / 1024.0f) + EPS);
          if (tz < 64) { const float rstd = 1.0f / sqrtf(ssf * (1.0f / 1024.0f) + EPS); float lg[8];
#pragma unroll
              for (int e = 0; e < 8; ++e) { float bl = 0.f;
#pragma unroll
                  for (int w2 = 0; w2 < 8; ++w2) bl += BL[w2 * 8 + e];
                  lg[e] = rstd * a4[e] + bl; }
              float v0 = lg[0];
#pragma unroll
              for (int e = 1; e < 8; ++e) if (lg[e] > v0) { v0 = lg[e]; e0 = e; }
              e1 = -1; float v1 = -3.0e38f;
#pragma unroll
              for (int e = 0; e < 8; ++e) if (e != e0 && lg[e] > v1) { v1 = lg[e]; e1 = e; }
              const float ex = __expf(v1 - v0), p0 = 1.0f / (1.0f + ex), p1 = ex * p0;
              te[2 * tok] = e0; te[2 * tok + 1] = e1; tp[2 * tok] = p0; tp[2 * tok + 1] = p1;
              r0 = __hip_atomic_fetch_add(hist + e0, 1, __ATOMIC_RELAXED, __HIP_MEMORY_SCOPE_WORKGROUP);
              r1 = __hip_atomic_fetch_add(hist + e1, 1, __ATOMIC_RELAXED, __HIP_MEMORY_SCOPE_WORKGROUP); } }
        asm volatile("s_waitcnt vmcnt(0) lgkmcnt(0)" ::: "memory"); __builtin_amdgcn_s_barrier(); asm volatile("" ::: "memory");
        int rbase = 0; if (tz < 8) rbase = atomicAdd(ecnt + tz, hist[tz]);
#pragma unroll
        for (int ai = 0; ai < 2; ++ai)
#pragma unroll
            for (int m = 0; m < 4; ++m) { const int rl = ai * HALF + wr * 64 + m * 16 + fr; const float rstd = S[rl]; const size_t urow = (size_t)(u.pm * BM + rl);
#pragma unroll
                for (int bj = 0; bj < 2; ++bj) { float h[8];
#pragma unroll
                    for (int n = 0; n < 2; ++n)
#pragma unroll
                        for (int j = 0; j < 4; ++j) h[4 * n + j] = acc[ai][bj][m][n][j] * rstd * ca[bj][n][j] + cb[bj][n][j];
                    u32x2 w8; w8.x = pack4_fp8(h[0], h[1], h[2], h[3]); w8.y = pack4_fp8(h[4], h[5], h[6], h[7]); *(u32x2*)(Uo + urow * D + col0 + bj * HALF) = w8; } }
        if (tz < 8) hist[8 + tz] = rbase;
        asm volatile("s_waitcnt vmcnt(0) lgkmcnt(0)" ::: "memory"); __builtin_amdgcn_s_barrier(); asm volatile("" ::: "memory");
        if (tz < 64) { ts[2 * tok] = r0 + hist[8 + e0]; ts[2 * tok + 1] = r1 + hist[8 + e1]; }
    }
};

struct EpiMerge {
    static constexpr bool PERM = true; static constexpr bool AFTER_DRAIN = false;
    const bf16_t* GT; bf16_t* M;
    __device__ __forceinline__ void operator()(Acc& acc, const Unit& u, int wr, int wc, int fr, int fq) const {
        const int row0 = u.pm * BM + wr * 64 + fr, col0 = u.pn * BM + wc * 32 + 8 * fq, seg = u.seg;
        const unsigned char* zt = (const unsigned char*)GT + (size_t)((u.pm * 3 + seg) * 4 + u.pn) * 65536 + (size_t)((((wr * 4 + wc) * 4 + fq) * 16 + fr) * 16);
        const size_t dnext = (seg < 2) ? (size_t)4 * 65536 : 0;
        u32x4 fw[2][4], dw[2][4];
#pragma unroll
        for (int ai = 0; ai < 2; ++ai)
#pragma unroll
            for (int m = 0; m < 4; ++m) { fw[ai][m] = *(const u32x4*)(zt + (ai * 4 + m) * 8192); dw[ai][m] = *(const u32x4*)(zt + dnext + (ai * 4 + m) * 8192); }
#pragma unroll
        for (int ai = 0; ai < 2; ++ai) {
#pragma unroll
            for (int m = 0; m < 4; ++m) { const size_t row = (size_t)(row0 + ai * HALF + m * 16);
#pragma unroll
                for (int bj = 0; bj < 2; ++bj) {
                    float f[8], d[8];
#pragma unroll
                    for (int j = 0; j < 8; ++j) { f[j] = (float)((fw[ai][m][2 * bj + (j >> 2)] >> (8 * (j & 3))) & 255u); d[j] = (float)((dw[ai][m][2 * bj + (j >> 2)] >> (8 * (j & 3))) & 255u); }
#pragma unroll
                    for (int j = 0; j < 8; ++j) f[j] = (seg < 2) ? f[j] * frcp(d[j]) : f[j] * (1.0f / 255.0f);
#pragma unroll
                    for (int n = 0; n < 2; ++n)
#pragma unroll
                        for (int j = 0; j < 4; ++j) acc[ai][bj][m][n][j] *= f[4 * n + j];
                    if (seg == 2) { const f32x4 v0 = acc[ai][bj][m][0], v1 = acc[ai][bj][m][1];
                        u32x4 w; w.x = cvt_pk_bf16(v0[0], v0[1]); w.y = cvt_pk_bf16(v0[2], v0[3]); w.z = cvt_pk_bf16(v1[0], v1[1]); w.w = cvt_pk_bf16(v1[2], v1[3]);
                        *(u32x4*)(M + row * D + col0 + bj * HALF) = w; } } }
        }
    }
};

struct SchedPlain {
    const char* A; const char* B; size_t a_ts, b_ts; int nM, nN, G, c, latonly;
    __device__ __forceinline__ bool next(int i, Unit& u) const {
        int pm, pn;
        if (latonly == 2) {
            const long L = (long)i * G + c;
            if (L < 64 * 28) { if (!tile_of(L, 64, 28, pm, pn)) return false; pm = 9 * (pm >> 3) + 1 + (pm & 7); }
            else { const int v = (int)(L - 64 * 28); if (v >= 8 * 6) return false; const int sx = v / 6, j = v - 6 * sx; pm = 9 * sx; pn = (j < 2) ? ZC_RX / 256 + j : ZC_K / 256 + (j - 2); }
        } else {
            if (!tile_of((long)i * G + c, nM, nN, pm, pn)) return false;
            if (latonly) pm = 9 * (pm >> 3) + 1 + (pm & 7); }
        u.pm = pm; u.pn = pn; u.seg = 0; u.aux = 0; u.A = A + (size_t)pm * a_ts; u.B = B + (size_t)pn * b_ts; return true;
    }
    __device__ __forceinline__ bool zero_after(const Unit&) const { return true; }
};
struct SchedGate {
    const char* A; const char* B; int G, c, redeal;
    __device__ __forceinline__ bool next(int i, Unit& u) const {
        long L = (long)i * G + c;
        if (redeal) { const int k = c - 64, k1 = c - 65; const bool isctx = k >= 0 && k % 6 == 0 && k / 6 < CH * 4, takes = k1 >= 0 && k1 % 6 == 0 && k1 / 6 < CH * 4;
            if (i == 1 && isctx) return false;
            if (i == 2 && takes) L = (long)G + (c - 1); }
        int pm, pn; if (!tile_of(L, CTILES, 8, pm, pn)) return false;
        u.pm = pm; u.pn = pn; u.seg = 0; u.aux = 0;
        u.A = A + (size_t)pm * (256 * 1024 * 2) + (size_t)(((pn >> 2) * 512 + ((pn & 3) >> 1) * 256) * 2); u.B = B + (size_t)pn * (256 * 256 * 2); return true;
    }
    __device__ __forceinline__ bool zero_after(const Unit&) const { return true; }
};
struct SchedMerge {
    const char* A; const char* B; int nM, G, c, latonly;
    __device__ __forceinline__ bool next(int i, Unit& u) const {
        const int ti = i / 3, seg = i - 3 * ti; int pm, pn; if (!tile_of((long)ti * G + c, nM, 4, pm, pn)) return false;
        if (latonly) pm = 9 * (pm >> 3) + 1 + (pm & 7);
        u.pm = pm; u.pn = pn; u.seg = seg; u.aux = 0;
        u.A = A + (size_t)pm * (256 * 1536 * 2) + (size_t)seg * 1024; u.B = B + (size_t)pn * (256 * 1536 * 2) + (size_t)seg * 1024; return true;
    }
    __device__ __forceinline__ bool zero_after(const Unit& u) const { return u.seg == 2; }
};
struct SchedMoe {
    const char* A; const char* B; size_t a_ts, b_ts, e_stride; int nM, nN, G, c; int pe[8];
    __device__ __forceinline__ bool next(int i, Unit& u) const {
        int pm, pn; if (!tile_of((long)i * G + c, nM, nN, pm, pn)) return false;
        int e = 0;
#pragma unroll
        for (int j = 0; j < 7; ++j) e += (pm * 256 >= pe[j]) ? 1 : 0;
        u.pm = pm; u.pn = pn; u.seg = 0; u.aux = e; u.A = A + (size_t)pm * a_ts; u.B = B + (size_t)e * e_stride + (size_t)pn * b_ts; return true;
    }
    __device__ __forceinline__ bool zero_after(const Unit&) const { return true; }
};
struct SchedMoeSplit {
    const char* A; const char* B; size_t a_ts, b_ts, e_stride; int nR, G, c; int pe[8];
    __device__ __forceinline__ bool next(int i, Unit& u) const {
        const long L = (long)i * G + c; if (L >= (long)nR * 8) return false;
        const int sl = (int)L & 1, pn = ((int)L >> 1) & 3, t = (int)L >> 3, pm = 128 + t;
        int e = 0;
#pragma unroll
        for (int j = 0; j < 7; ++j) e += (pm * 256 >= pe[j]) ? 1 : 0;
        u.pm = sl * 8 + t; u.pn = pn; u.seg = 0; u.aux = e;
        u.A = A + (size_t)pm * a_ts + (size_t)sl * 1792; u.B = B + (size_t)e * e_stride + (size_t)pn * b_ts + (size_t)sl * 1792; return true;
    }
    __device__ __forceinline__ bool zero_after(const Unit&) const { return true; }
};
}

namespace att {
constexpr int NW = 8, QBLK = 32, KVBLK = 64;
constexpr float SCALE = 0.125f;
constexpr float THR = 8.f;
constexpr int LDK = ZLD;
constexpr int SHM_V = KVBLK * 128 * 2, SHM_K = KVBLK * 64 * 2;
#define KSWZ64(row, colB) ((row) * 128 + ((colB) ^ ((((row) >> 1) & 7) << 4)))
#define SBAR() __builtin_amdgcn_sched_barrier(0)
__device__ __forceinline__ int crow(int r, int hi) { return (r & 3) + 8 * (r >> 2) + 4 * hi; }
__device__ __forceinline__ unsigned cvtpk(float lo, float hi) { unsigned r; asm volatile("v_cvt_pk_bf16_f32 %0, %1, %2" : "=v"(r) : "v"(lo), "v"(hi)); return r; }

__device__ __forceinline__ void partialSM(f32x16& p0, f32x16& p1, float& m_reg, float& mn, float& alpha) {
  constexpr float C = SCALE * 1.4426950408889634f;
  float pmax = p0[0];
#pragma unroll
  for (int r = 1; r < 16; ++r) pmax = fmaxf(pmax, p0[r]);
#pragma unroll
  for (int r = 0; r < 16; ++r) pmax = fmaxf(pmax, p1[r]);
  { auto rr = __builtin_amdgcn_permlane32_swap(__float_as_uint(pmax), __float_as_uint(pmax), false, false);
    pmax = fmaxf(__uint_as_float(rr[0]), __uint_as_float(rr[1])); }
  if (__builtin_expect(__all(pmax - m_reg <= THR / SCALE), 1)) { mn = m_reg; alpha = 1.f; }
  else { mn = fmaxf(m_reg, pmax); alpha = __builtin_amdgcn_exp2f((m_reg - mn) * C); m_reg = mn; }
  float mnC = -mn * C;
#pragma unroll
  for (int r = 0; r < 16; ++r) p0[r] = fmaf(p0[r], C, mnC);
#pragma unroll
  for (int r = 0; r < 16; ++r) p1[r] = fmaf(p1[r], C, mnC);
#pragma unroll
  for (int r = 0; r < 16; ++r) p0[r] = __builtin_amdgcn_exp2f(p0[r]);
}
__device__ __forceinline__ void finishSM(f32x16& p0, f32x16& p1, float alpha, float& l_reg, bf16x8& pa0, bf16x8& pa1, bf16x8& pa2, bf16x8& pa3) {
#pragma unroll
  for (int r = 0; r < 16; ++r) p1[r] = __builtin_amdgcn_exp2f(p1[r]);
  float ps = 0;
#pragma unroll
  for (int r = 0; r < 16; ++r) ps += p0[r];
#pragma unroll
  for (int r = 0; r < 16; ++r) ps += p1[r];
  { auto rr = __builtin_amdgcn_permlane32_swap(__float_as_uint(ps), __float_as_uint(ps), false, false);
    ps = __uint_as_float(rr[0]) + __uint_as_float(rr[1]); }
  l_reg = l_reg * alpha + ps;
#define PK4(P, BASE, OUT) do { unsigned a0 = cvtpk(P[BASE + 0], P[BASE + 1]), a1 = cvtpk(P[BASE + 2], P[BASE + 3]);   \
    unsigned b0 = cvtpk(P[BASE + 4], P[BASE + 5]), b1 = cvtpk(P[BASE + 6], P[BASE + 7]);                              \
    auto r0 = __builtin_amdgcn_permlane32_swap(a0, b0, false, false); auto r1 = __builtin_amdgcn_permlane32_swap(a1, b1, false, false); \
    u32x4 w = {r0[0], r1[0], r0[1], r1[1]}; OUT = *reinterpret_cast<bf16x8*>(&w); } while (0)
  PK4(p0, 0, pa0); PK4(p0, 8, pa1); PK4(p1, 0, pa2); PK4(p1, 8, pa3);
#undef PK4
}
__device__ __forceinline__ void qkt(f32x16& p0, f32x16& p1, const char* Ks, const bf16x8 (&qr)[4], int r32, int hi) {
  p0 = f32x16{}; p1 = f32x16{};
#pragma unroll
  for (int d0 = 0; d0 < 4; ++d0) { const int cb = (d0 * 16 + hi * 8) * 2;
    bf16x8 b0 = *reinterpret_cast<const bf16x8*>(Ks + KSWZ64(r32, cb));
    bf16x8 b1 = *reinterpret_cast<const bf16x8*>(Ks + KSWZ64(32 + r32, cb));
    p0 = __builtin_amdgcn_mfma_f32_32x32x16_bf16(b0, qr[d0], p0, 0, 0, 0);
    p1 = __builtin_amdgcn_mfma_f32_32x32x16_bf16(b1, qr[d0], p1, 0, 0, 0); }
}
__device__ __forceinline__ int v_st(int k, int c) { const int kk = (k & ~0xC) | ((k & 4) << 1) | ((k & 8) >> 1); return ((kk >> 3) * 4 + (c >> 5)) * 512 + ((kk & 7) * 32 + (c & 31)) * 2; }
__device__ __forceinline__ int v_rd_base(int lane) { return ((lane & 3) << 3) | (((lane >> 2) & 3) << 6) | (((lane >> 4) & 1) << 5) | (((lane >> 5) & 1) << 8); }
constexpr int v_rd_off(int d0, int ks, int half) { return d0 * 512 + ks * 4096 + half * 2048; }
template <int OFF> __device__ __forceinline__ s16x4 tr_read(int vb) {
  s16x4 r; asm volatile("ds_read_b64_tr_b16 %0, %1 offset:%2" : "=&v"(r) : "v"(vb), "i"(OFF) : "memory"); return r;
}
template <int D0> __device__ __forceinline__ void pv_one(f32x16& od, int vb, bf16x8 pa0, bf16x8 pa1, bf16x8 pa2, bf16x8 pa3) {
  const s16x4 l0 = tr_read<v_rd_off(D0, 0, 0)>(vb), h0 = tr_read<v_rd_off(D0, 0, 1)>(vb), l1 = tr_read<v_rd_off(D0, 1, 0)>(vb), h1 = tr_read<v_rd_off(D0, 1, 1)>(vb);
  const s16x4 l2 = tr_read<v_rd_off(D0, 2, 0)>(vb), h2 = tr_read<v_rd_off(D0, 2, 1)>(vb), l3 = tr_read<v_rd_off(D0, 3, 0)>(vb), h3 = tr_read<v_rd_off(D0, 3, 1)>(vb);
  asm volatile("s_waitcnt lgkmcnt(0)" ::: "memory"); SBAR();
#define PK(L, H) (bf16x8){L[0], L[1], L[2], L[3], H[0], H[1], H[2], H[3]}
  od = __builtin_amdgcn_mfma_f32_32x32x16_bf16(pa0, PK(l0, h0), od, 0, 0, 0);
  od = __builtin_amdgcn_mfma_f32_32x32x16_bf16(pa1, PK(l1, h1), od, 0, 0, 0);
  od = __builtin_amdgcn_mfma_f32_32x32x16_bf16(pa2, PK(l2, h2), od, 0, 0, 0);
  od = __builtin_amdgcn_mfma_f32_32x32x16_bf16(pa3, PK(l3, h3), od, 0, 0, 0);
#undef PK
}
__device__ __forceinline__ void pv_d0(f32x16 (&o)[4], int vb, bf16x8 pa0, bf16x8 pa1, bf16x8 pa2, bf16x8 pa3) {
  pv_one<0>(o[0], vb, pa0, pa1, pa2, pa3); pv_one<1>(o[1], vb, pa0, pa1, pa2, pa3); pv_one<2>(o[2], vb, pa0, pa1, pa2, pa3); pv_one<3>(o[3], vb, pa0, pa1, pa2, pa3);
}

struct KVStage { bf16x8 vs0, vs1, ks0; };
__device__ __forceinline__ void attn_map(const bf16_t* __restrict__ Qb, const bf16_t* __restrict__ Kh, const bf16_t* __restrict__ Vh, int seq, char* lds, f32x16 (&o)[4],
                                         const bf16_t* __restrict__ Kn, const bf16_t* __restrict__ Vn, bf16x8& pre_v0, bf16x8& pre_v1, bf16x8& pre_k0, bool have_pre) {
  const int tid = otid(), wid = tid >> 6, lane = tid & 63, r32 = lane & 31, hi = lane >> 5;
  char* V_lds = lds; char* K_lds = lds + 2 * SHM_V;
  float* ws = (float*)(lds + 2 * SHM_V + 2 * SHM_K) + wid * 64; float* li_l = ws; float* al_l = ws + 32;
  float m_reg = -1e30f, l_reg = 0; bf16x8 qr[4];
#pragma unroll
  for (int d = 0; d < 4; ++d) o[d] = f32x16{};
  const bf16_t* Qw = Qb + (long)(wid * QBLK + r32) * LDK + hi * 8;
#pragma unroll
  for (int d0 = 0; d0 < 4; ++d0) qr[d0] = *reinterpret_cast<const bf16x8*>(Qw + d0 * 16);
  const int sr = tid >> 4, sc = (tid & 15) * 8, vst0 = v_st(sr, sc), vst1 = v_st(32 + sr, sc);
  const int kr = tid >> 3, kc = (tid & 7) * 8, kst = KSWZ64(kr, kc * 2);
  const int vb0 = (int)(uintptr_t)V_lds + v_rd_base(lane);
  KVStage sr_[2];
#define SLOAD(i, k0) do { sr_[i].vs0 = *reinterpret_cast<const bf16x8*>(&Vh[(long)((k0) + sr) * LDK + sc]); sr_[i].vs1 = *reinterpret_cast<const bf16x8*>(&Vh[(long)((k0) + 32 + sr) * LDK + sc]); \
    sr_[i].ks0 = *reinterpret_cast<const bf16x8*>(&Kh[(long)((k0) + kr) * LDK + kc]); } while (0)
#define SWRITE(b, i) do { *(bf16x8*)(V_lds + (b) * SHM_V + vst0) = sr_[i].vs0; *(bf16x8*)(V_lds + (b) * SHM_V + vst1) = sr_[i].vs1; \
    *(bf16x8*)(K_lds + (b) * SHM_K + kst) = sr_[i].ks0; } while (0)
#define SWAIT() asm volatile("s_waitcnt vmcnt(3)" ::: "memory")
#define RESC(a) do { if (__any((a) < 1.f)) { if (hi == 0) al_l[r32] = (a); asm volatile("s_waitcnt lgkmcnt(0)" ::: "memory"); \
    _Pragma("unroll") for (int d = 0; d < 4; ++d) _Pragma("unroll") for (int r = 0; r < 16; ++r) o[d][r] *= al_l[crow(r, hi)]; } } while (0)
  f32x16 pA0, pA1, pB0, pB1; float mnA, mnB, alA, alB; bf16x8 pa0, pa1, pa2, pa3; const int NT = seq / KVBLK;
  constexpr int SE = 0, SO = 1;
  if (__builtin_amdgcn_readfirstlane(tid) >= 256) __builtin_amdgcn_s_setprio(1);
#define SLOADN(i) do { sr_[i].vs0 = *reinterpret_cast<const bf16x8*>(&Vn[(long)(sr) * LDK + sc]); sr_[i].vs1 = *reinterpret_cast<const bf16x8*>(&Vn[(long)(32 + sr) * LDK + sc]); \
    sr_[i].ks0 = *reinterpret_cast<const bf16x8*>(&Kn[(long)(kr) * LDK + kc]); } while (0)
  if (have_pre) { sr_[SE].vs0 = pre_v0; sr_[SE].vs1 = pre_v1; sr_[SE].ks0 = pre_k0; } else SLOAD(SE, 0);
  asm volatile("s_waitcnt vmcnt(0)" ::: "memory"); SWRITE(0, SE); __syncthreads();
  qkt(pA0, pA1, K_lds, qr, r32, hi); partialSM(pA0, pA1, m_reg, mnA, alA);
  SLOAD(SO, KVBLK); if (2 < NT) SLOAD(SE, 2 * KVBLK);
  SWAIT(); SWRITE(1, SO); __syncthreads();
  for (int j = 1; j + 1 < NT; j += 2) {
    SBAR(); qkt(pB0, pB1, K_lds + SHM_K, qr, r32, hi);
    finishSM(pA0, pA1, alA, l_reg, pa0, pa1, pa2, pa3); SBAR();
    SLOAD(SO, (j + 2) * KVBLK); SBAR();
    pv_d0(o, vb0, pa0, pa1, pa2, pa3); partialSM(pB0, pB1, m_reg, mnB, alB);
    __syncthreads(); SWAIT(); SWRITE(0, SE);
    RESC(alB); __syncthreads();
    SBAR(); qkt(pA0, pA1, K_lds, qr, r32, hi);
    finishSM(pB0, pB1, alB, l_reg, pa0, pa1, pa2, pa3); SBAR();
    if (j + 3 < NT) SLOAD(SE, (j + 3) * KVBLK); else SLOADN(SE); SBAR();
    pv_d0(o, vb0 + SHM_V, pa0, pa1, pa2, pa3); partialSM(pA0, pA1, m_reg, mnA, alA);
    __syncthreads(); SWAIT(); SWRITE(1, SO);
    RESC(alA); __syncthreads();
  }
  SBAR(); qkt(pB0, pB1, K_lds + SHM_K, qr, r32, hi);
  finishSM(pA0, pA1, alA, l_reg, pa0, pa1, pa2, pa3); SBAR();
  pv_d0(o, vb0, pa0, pa1, pa2, pa3); partialSM(pB0, pB1, m_reg, mnB, alB);
  __syncthreads(); RESC(alB);
  finishSM(pB0, pB1, alB, l_reg, pa0, pa1, pa2, pa3); SBAR();
  pv_d0(o, vb0 + SHM_V, pa0, pa1, pa2, pa3);
  __builtin_amdgcn_s_setprio(0);
  if (hi == 0) li_l[r32] = l_reg; asm volatile("s_waitcnt lgkmcnt(0)" ::: "memory");
#pragma unroll
  for (int r = 0; r < 16; ++r) { const float rl = __builtin_amdgcn_rcpf(li_l[crow(r, hi)]);
#pragma unroll
    for (int d = 0; d < 4; ++d) o[d][r] *= rl; }
  pre_v0 = sr_[SE].vs0; pre_v1 = sr_[SE].vs1; pre_k0 = sr_[SE].ks0;
#undef SLOAD
#undef SLOADN
#undef SWRITE
#undef SWAIT
#undef RESC
}
}

struct Args { const float* in[27]; float* out; unsigned char* ws; int ph_lo, ph_hi; };
enum { I_X = 0, I_C, I_CTX, I_CCTX, I_MODW, I_MODB, I_N1W, I_N2W, I_WIN, I_CONVA, I_RGCW, I_RGCB, I_RGWA, I_RGBA, I_RGWX, I_RGBX, I_RGLAM, I_DALAM, I_SUBLN, I_WBR, I_WOUT,
       I_F13, I_F2, I_ROUTER, I_M13, I_M2, I_FNW };

__device__ __forceinline__ void p0_mod(const Args& a, LAS unsigned char* lds) {
    LAS float* S = (LAS float*)lds;
    const int tid = otid(), wave = tid >> 6, lane = tid & 63;
    float* MOD = (float*)(a.ws + WS_MOD);
    for (int item = blockIdx.x; item < 192; item += gridDim.x) {
        const int l = item / 96, cb = item - 96 * l, j = cb * 64 + lane;
        for (int i = tid; i < 33 * 1024; i += NTHREADS) { const int r = i >> 10, k = i & 1023; const float v = (r < 32) ? a.in[I_C][r * 1024 + k] : a.in[I_CCTX][k]; S[i] = v * sigmoidf_(v); }
        __syncthreads();
        float acc[33];
#pragma unroll
        for (int r = 0; r < 33; ++r) acc[r] = 0.f;
        const float* wp = a.in[I_MODW] + (size_t)l * 1024 * 6144 + j;
        for (int k = wave * 128; k < wave * 128 + 128; k += 16) {
            float w[16];
#pragma unroll
            for (int q = 0; q < 16; ++q) w[q] = wp[(size_t)(k + q) * 6144];
#pragma unroll
            for (int r = 0; r < 33; ++r) {
#pragma unroll
                for (int q = 0; q < 16; q += 4) { const f32x4 s = *(const LAS f32x4*)(S + r * 1024 + k + q); acc[r] += s[0] * w[q] + s[1] * w[q + 1] + s[2] * w[q + 2] + s[3] * w[q + 3]; } }
        }
        __syncthreads();
#pragma unroll
        for (int r = 0; r < 33; ++r) S[(wave * 33 + r) * 64 + lane] = acc[r];
        __syncthreads();
        for (int o = tid; o < 33 * 64; o += NTHREADS) { const int r = o >> 6, ln = o & 63; float s = a.in[I_MODB][l * 6144 + cb * 64 + ln];
#pragma unroll
            for (int w = 0; w < 8; ++w) s += S[(w * 33 + r) * 64 + ln];
            MOD[((size_t)l * 33 + r) * 6144 + cb * 64 + ln] = s; }
        __syncthreads();
    }
}
__device__ __forceinline__ void cvt_mat(LAS unsigned char* lds, const float* src, int K, int N, bf16_t* dst, int ldd, int coff, int mode, int rot, bool f8 = false, int wi = -1, int nw = 0) {
    LAS float* T = (LAS float*)lds;
    const int tid = otid(), tn = N / 128, nt = (K / 128) * tn, G = wi < 0 ? (int)gridDim.x : nw, b0 = wi < 0 ? (int)blockIdx.x : wi;
    for (int t = (b0 + rot) % G; t < nt; t += G) {
        const int k0 = (t / tn) * 128, n0 = (t % tn) * 128;
        f32x4 ld[8];
#pragma unroll
        for (int i = 0; i < 8; ++i) { const int k = (tid >> 5) + 16 * i, n = (tid & 31) * 4; ld[i] = __builtin_nontemporal_load((const f32x4*)(src + (size_t)(k0 + k) * N + n0 + n)); }
#pragma unroll
        for (int i = 0; i < 8; ++i) { const int k = (tid >> 5) + 16 * i, n = (tid & 31) * 4; LAS float* tp = T + k * 129 + n; tp[0] = ld[i][0]; tp[1] = ld[i][1]; tp[2] = ld[i][2]; tp[3] = ld[i][3]; }
        __syncthreads();
#pragma unroll
        for (int pz = 0; pz < 4; ++pz) { const int n = (tid >> 4) + 32 * pz, k8 = (tid & 15) * 8; float v[8];
#pragma unroll
          for (int j = 0; j < 8; ++j) v[j] = T[(k8 + j) * 129 + n];
          const int nn = n0 + n; int nd = nn;
          if (mode == 1) { const int q = (nn < FF) ? nn : nn - FF; nd = 256 * (q >> 7) + (q & 127) + ((nn < FF) ? 0 : 128); }
          if (mode == 2 && nn >= ZC_AC && nn < ZC_RG) {
              const int c = nn - ZC_AC, chn = c & 511; nd = ZC_AC + (chn >> 7) * 256 + (c >= 512 ? 128 : 0) + (chn & 127); }
          if (mode == 2 && nn >= ZC_Q && nn < ZC_V) {
              const int j = nn & 255, vec = j >> 6, d = j & 63; nd = (nn & ~255) + ((d >> 4) & 1) * 128 + vec * 32 + (d >> 5) * 16 + (d & 15); }
          if (f8) { u32x2 w8; w8.x = pack4_fp8(v[0] * 64.f, v[1] * 64.f, v[2] * 64.f, v[3] * 64.f); w8.y = pack4_fp8(v[4] * 64.f, v[5] * 64.f, v[6] * 64.f, v[7] * 64.f);
              *(u32x2*)((unsigned char*)dst + (size_t)nd * ldd + coff + k0 + k8) = w8; }
          else *(u32x4*)(dst + (size_t)nd * ldd + coff + k0 + k8) = pack8(v); }
        __syncthreads();
    }
}
__device__ __forceinline__ void p0_misc(const Args& a) {
    const int gtid = blockIdx.x * NTHREADS + otid(), gsz = gridDim.x * NTHREADS;
    bf16_t* WG = (bf16_t*)(a.ws + WS_WG);
    for (int i = gtid; i < 2 * 8 * 256 * 32; i += gsz) {
        const int k8 = (i & 31) * 8, n = (i >> 5) & 255, t8 = (i >> 13) & 7, l = i >> 16;
        const int dir = t8 >> 2, q = t8 & 3, gate = n >> 7, ch = 128 * q + (n & 127), g = ch >> 6, j = ch & 63, inch = 256 * (q >> 1) + k8, gk = inch >> 6, i0 = inch & 63;
        const float* w = (gate ? a.in[I_RGWX] : a.in[I_RGWA]) + (((size_t)(l * 2 + dir) * 8 + g) * 64) * 64;
        float v[8];
#pragma unroll
        for (int qq = 0; qq < 8; ++qq) v[qq] = (g == gk) ? w[(i0 + qq) * 64 + j] : 0.f;
        *(u32x4*)(WG + (size_t)i * 8) = pack8(v);
    }
    float* GB = (float*)(a.ws + WS_GB);
    for (int i = gtid; i < 2 * 2048; i += gsz) { const int l = i >> 11, col = i & 2047, t8 = col >> 8, n = col & 255, dir = t8 >> 2, q = t8 & 3, gate = n >> 7, ch = 128 * q + (n & 127);
        GB[i] = (gate ? a.in[I_RGBX] : a.in[I_RGBA])[(l * 2 + dir) * 512 + ch]; }
    float* CF = (float*)(a.ws + WS_COEF);
    for (int i = gtid; i < 2 * 1024; i += gsz) { const float lam = a.in[I_RGLAM][i]; CF[i] = -8.0f * log1pf(expf(-lam)) * 1.4426950408889634f; }
    float* RC = (float*)(a.ws + WS_ROPE); float* RS = RC + 2048 * 32;
    for (int i = gtid; i < 2048 * 32; i += gsz) { const int t = i >> 5, ax = (i >> 4) & 1, q = i & 15;
        const float inv = powf(10000.0f, -(float)(2 * q) / 32.0f); const float pos = (float)(ax ? (t & 63) : (t >> 6)); const float ang = pos * inv;
        RC[i] = cosf(ang); RS[i] = sinf(ang); }
    if (gtid < 2) { const int l = gtid; const float* lf = a.in[I_DALAM] + l * 256; float s1 = 0.f, s2 = 0.f;
        for (int q = 0; q < 64; ++q) { s1 += lf[q] * lf[64 + q]; s2 += lf[128 + q] * lf[192 + q]; }
        const float lam_init = 0.8f - 0.6f * expf(-0.3f * (float)l);
        ((float*)(a.ws + WS_LAM))[l] = expf(s1) - expf(s2) + lam_init; }
}
__device__ __forceinline__ void cvt_m13(const Args& a, LAS unsigned char* lds, int e, int wi, int nw) {
    cvt_mat(lds, a.in[I_M13] + (size_t)e * D * DIN, D, DIN, (bf16_t*)(a.ws + WS_M13 + (size_t)e * DIN * D), D, 0, 1, e * 32, true, wi, nw); }
__device__ __forceinline__ void cvt_m2(const Args& a, LAS unsigned char* lds, int e, int wi, int nw) {
    cvt_mat(lds, a.in[I_M2] + (size_t)e * FF * D, FF, D, (bf16_t*)(a.ws + WS_M2 + (size_t)e * D * FF), FF, 0, 0, e * 32 + 16, true, wi, nw); }
__device__ __forceinline__ void phase_prologue(const Args& a, LAS unsigned char* lds) {
    p0_mod(a, lds);
    __syncthreads();
    unsigned char* ws = a.ws; int rot = 0;
    for (int l = 0; l < 2; ++l) {
        cvt_mat(lds, a.in[I_WIN] + (size_t)l * D * DIN, D, DIN, (bf16_t*)(ws + WS_WIN) + (size_t)l * DIN * D, D, 0, 2, rot); rot += 64;
        for (int br = 0; br < 3; ++br) { cvt_mat(lds, a.in[I_WBR] + ((size_t)l * 3 + br) * 512 * D, 512, D, (bf16_t*)(ws + WS_WBR) + (size_t)l * D * 1536, 1536, br * 512, 0, rot); rot += 128; }
        cvt_mat(lds, a.in[I_WOUT] + (size_t)l * D * D, D, D, (bf16_t*)(ws + WS_WOUT) + (size_t)l * D * D, D, 0, 0, rot); rot += 64;
    }
    cvt_mat(lds, a.in[I_F13], D, DIN, (bf16_t*)(ws + WS_F13), D, 0, 1, rot, DENSE_F8);
    cvt_mat(lds, a.in[I_F2], FF, D, (bf16_t*)(ws + WS_F2), FF, 0, 0, rot + 128, DENSE_F8);
    for (int e = 0; e < NEXP; ++e) { cvt_m13(a, lds, e, -1, 0); cvt_m2(a, lds, e, -1, 0); }
    p0_misc(a);
}
__device__ __forceinline__ void cvt_late(const Args& a, LAS unsigned char* lds, int part) {
    const int G = gridDim.x, nw = (G > 128) ? G - 128 : G, wi = (G > 128) ? (int)blockIdx.x - 128 : (int)blockIdx.x;
    if (wi < 0) return;
    if (part == 0) { cvt_m13(a, lds, 4, wi, nw); cvt_m13(a, lds, 5, wi, nw); }
    else if (part == 1) { cvt_m2(a, lds, 4, wi, nw); cvt_m2(a, lds, 5, wi, nw); }
    else { cvt_m13(a, lds, 6, wi, nw); cvt_m13(a, lds, 7, wi, nw); cvt_m2(a, lds, 6, wi, nw); }
}

template <bool ROUTER>
__device__ __forceinline__ void phase_norm(const Args& a, int l, int c, int which, bool skipctx, LAS unsigned char* lds, bool probe = false, bool ctxall = false) {
    const int tid = otid(), wave = tid >> 6, lane = tid & 63;
    LAS int* hist = (LAS int*)lds;
    if (ROUTER) { if (tid < 16) hist[tid] = 0; __syncthreads(); }
    const float* MOD = (const float*)(a.ws + WS_MOD) + (size_t)l * 33 * 6144;
    const float* nw = (which ? a.in[I_N2W] : a.in[I_N1W]) + l * D;
    const bool first = (l == 0 && which == 0);
    const float* lat_src = a.in[I_X]; const float* ctx_src = a.in[I_CTX];
    const bf16_t* lat_b = (const bf16_t*)(a.ws + WS_XB); const bf16_t* ctx_b = (const bf16_t*)(a.ws + WS_CX);
    bf16_t* U = (bf16_t*)(a.ws + WS_U);
    f32x4 nwv[4];
#pragma unroll
    for (int i = 0; i < 4; ++i) nwv[i] = *(const f32x4*)(nw + lane * 4 + 256 * i);
    f32x4 rw[4][4][2];
    if (ROUTER) {
#pragma unroll
        for (int i = 0; i < 4; ++i)
#pragma unroll
            for (int q = 0; q < 4; ++q) { const float* rp = a.in[I_ROUTER] + (size_t)(lane * 4 + 256 * i + q) * 8; rw[i][q][0] = *(const f32x4*)rp; rw[i][q][1] = *(const f32x4*)(rp + 4); } }
    const int nrows = ctxall ? NB * CTXL : (skipctx ? CH * SEQ : CROWS);
    const int per = (nrows + (int)gridDim.x * 8 - 1) / ((int)gridDim.x * 8), qb = ((int)blockIdx.x * 8 + wave) * per, qe = (qb + per < nrows) ? qb + per : nrows;
#define NRM_ROW(Q) (ctxall ? (Q) : (skipctx ? ((Q) >> 11) * TOK + CTXL + ((Q) & 2047) : (Q)))
#define NRM_LOAD(Q, RAW) do { const int r_ = NRM_ROW(Q), s_ = ctxall ? (r_ >> 8) : r_ / TOK, w_ = ctxall ? (r_ & 255) : r_ - s_ * TOK, b_ = ctxall ? s_ : c * CH + s_; const bool ic_ = w_ < CTXL; \
        const size_t so_ = (ic_ ? ((size_t)b_ * CTXL + w_) * D : ((size_t)b_ * SEQ + (w_ - CTXL)) * D) + lane * 4; \
        if (first) { const float* p_ = (ic_ ? ctx_src : lat_src) + so_; _Pragma("unroll") for (int i = 0; i < 4; ++i) { const f32x4 t_ = *(const f32x4*)(p_ + 256 * i); RAW[i] = (u32x4){__float_as_uint(t_[0]), __float_as_uint(t_[1]), __float_as_uint(t_[2]), __float_as_uint(t_[3])}; } } \
        else { const bf16_t* p_ = (ic_ ? ctx_b : lat_b) + so_; _Pragma("unroll") for (int i = 0; i < 4; ++i) { const u32x2 t_ = *(const u32x2*)(p_ + 256 * i); RAW[i] = (u32x4){t_.x, t_.y, 0u, 0u}; } } } while (0)
    u32x4 rawc[4], rawn[4];
    f32x4 shv[4], scv[4]; int mkey = -1;
    if (qb < qe) NRM_LOAD(qb, rawc);
    for (int q = qb; q < qe; ++q) {
        { const int qn = (q + 1 < qe) ? q + 1 : qe - 1; NRM_LOAD(qn, rawn); }
        const int r = NRM_ROW(q);
        const int s = ctxall ? (r >> 8) : r / TOK, w = ctxall ? (r & 255) : r - s * TOK, b = ctxall ? s : c * CH + s; const bool isctx = w < CTXL;
        { const int key = isctx ? 32 : b;
          if (key != mkey) { const float* mr_ = MOD + (size_t)key * 6144 + which * 3072 + lane * 4;
#pragma unroll
              for (int i = 0; i < 4; ++i) { shv[i] = *(const f32x4*)(mr_ + 256 * i); scv[i] = *(const f32x4*)(mr_ + 1024 + 256 * i); }
              mkey = key; } }
        f32x4 v[4]; float ss = 0.f;
#pragma unroll
        for (int i = 0; i < 4; ++i) {
            if (first) v[i] = (f32x4){__uint_as_float(rawc[i].x), __uint_as_float(rawc[i].y), __uint_as_float(rawc[i].z), __uint_as_float(rawc[i].w)};
            else v[i] = (f32x4){__uint_as_float(rawc[i].x << 16), __uint_as_float(rawc[i].x & 0xffff0000u), __uint_as_float(rawc[i].y << 16), __uint_as_float(rawc[i].y & 0xffff0000u)};
            ss += v[i][0] * v[i][0] + v[i][1] * v[i][1] + v[i][2] * v[i][2] + v[i][3] * v[i][3]; }
#pragma unroll
        for (int i = 0; i < 4; ++i) rawc[i] = rawn[i];
        ss = wave_sum(ss);
        const float rstd = 1.0f / sqrtf(ss * (1.0f / 1024.0f) + EPS);
        float lg[8];
        if (ROUTER) {
#pragma unroll
            for (int e = 0; e < 8; ++e) lg[e] = 0.f; }
#pragma unroll
        for (int i = 0; i < 4; ++i) { const int col = lane * 4 + 256 * i;
            const f32x4 sh = shv[i], sc = scv[i];
            f32x4 h = (v[i] * rstd * nwv[i]) * (sc + 1.0f) + sh;
            if (which == 1 && (ROUTER || DENSE_F8)) *(unsigned*)((unsigned char*)U + (size_t)r * D + col) = pack4_fp8(h[0], h[1], h[2], h[3]);
            else { u32x2 pk; pk.x = cvt_pk_bf16(h[0], h[1]); pk.y = cvt_pk_bf16(h[2], h[3]);
                *(u32x2*)(U + (size_t)r * D + col) = pk; }
            if (ROUTER) {
#pragma unroll
                for (int q = 0; q < 4; ++q) { const f32x4 r0 = rw[i][q][0], r1 = rw[i][q][1];
                    lg[0] += h[q] * r0[0]; lg[1] += h[q] * r0[1]; lg[2] += h[q] * r0[2]; lg[3] += h[q] * r0[3];
                    lg[4] += h[q] * r1[0]; lg[5] += h[q] * r1[1]; lg[6] += h[q] * r1[2]; lg[7] += h[q] * r1[3]; } } }
        if (ROUTER) {
#pragma unroll
            for (int e = 0; e < 8; ++e) lg[e] = wave_sum(lg[e]);
            int e0 = 0; float v0 = lg[0];
#pragma unroll
            for (int e = 1; e < 8; ++e) if (lg[e] > v0) { v0 = lg[e]; e0 = e; }
            int e1 = -1; float v1 = -3.0e38f;
#pragma unroll
            for (int e = 0; e < 8; ++e) if (e != e0 && lg[e] > v1) { v1 = lg[e]; e1 = e; }
            const float ex = __expf(v1 - v0), p0 = 1.0f / (1.0f + ex), p1 = ex * p0;
            if (lane == 0) { const int t = s * SEQ + (w - CTXL);
                int* te = (int*)(a.ws + WS_TOKE); float* tp = (float*)(a.ws + WS_TOKP); int* ts = (int*)(a.ws + WS_TOKS);
                te[2 * t] = e0; te[2 * t + 1] = e1; tp[2 * t] = p0; tp[2 * t + 1] = p1;
                ts[2 * t] = __hip_atomic_fetch_add(hist + e0, 1, __ATOMIC_RELAXED, __HIP_MEMORY_SCOPE_WORKGROUP);
                ts[2 * t + 1] = __hip_atomic_fetch_add(hist + e1, 1, __ATOMIC_RELAXED, __HIP_MEMORY_SCOPE_WORKGROUP); }
        }
    }
    if (ROUTER) {
        __syncthreads();
        if (tid < 8) { int* cnt = (int*)(a.ws + WS_CTL + CTL_CNT) + c * 32 + (probe ? 8 : 0); hist[8 + tid] = atomicAdd(cnt + tid, hist[tid]); }
        __syncthreads();
        if (lane == 0) {
            const int* te = (const int*)(a.ws + WS_TOKE); int* ts = (int*)(a.ws + WS_TOKS);
            for (int q = qb; q < qe; ++q) {
                const int r = NRM_ROW(q), s = r / TOK, w = r - s * TOK; if (w < CTXL) continue;
                const int t = s * SEQ + (w - CTXL);
                ts[2 * t] += hist[8 + te[2 * t]]; ts[2 * t + 1] += hist[8 + te[2 * t + 1]]; }
        }
    }
#undef NRM_ROW
#undef NRM_LOAD
}

#define ELM_UNP4(P, F) do { F[0] = __uint_as_float((P).x << 16); F[1] = __uint_as_float((P).x & 0xffff0000u); F[2] = __uint_as_float((P).y << 16); F[3] = __uint_as_float((P).y & 0xffff0000u); } while (0)
template <bool MASK>
__device__ __forceinline__ void elem_run(const bf16_t* Z, bf16_t* XC, bf16_t* YC, const float* caw, const float* rcw, const float* rcb, int r0, int ch) {
    constexpr int RL = 9, LA = 3;
#define ELM_ROWC(OFF) (MASK ? ((r0 + (OFF)) < 0 ? 0 : ((r0 + (OFF)) >= CROWS ? CROWS - 1 : r0 + (OFF))) : r0 + (OFF))
#define ELM_SID(OFF) ((r0 + (OFF)) < 0 || (r0 + (OFF)) >= CROWS ? -1 : 2 * ((r0 + (OFF)) / TOK) + (((r0 + (OFF)) % TOK) >= CTXL ? 1 : 0))
#define ELM_MSK(P, OFF_IN, OFF_OUT) ((!MASK || ELM_SID(OFF_IN) == ELM_SID(OFF_OUT)) ? (P) : (u32x2){0u, 0u})
    const bf16_t* zb = Z + ch;
    {
        f32x4 wa[3];
#pragma unroll
        for (int k = 0; k < 3; ++k) wa[k] = *(const f32x4*)(caw + k * 512 + ch);
        u32x2 pw[RL + 2], abw[RL];
#pragma unroll
        for (int i = 0; i < 3 + LA; ++i) pw[i] = *(const u32x2*)(zb + (size_t)ELM_ROWC(i - 1) * ZLD + ZC_AC);
#pragma unroll
        for (int i = 0; i < 1 + LA; ++i) abw[i] = *(const u32x2*)(zb + (size_t)ELM_ROWC(i) * ZLD + ZC_AB);
#pragma unroll
        for (int j = 0; j < RL; ++j) {
            if (j + 3 + LA < RL + 2) pw[j + 3 + LA] = *(const u32x2*)(zb + (size_t)ELM_ROWC(j + 2 + LA) * ZLD + ZC_AC);
            if (j + 1 + LA < RL) abw[j + 1 + LA] = *(const u32x2*)(zb + (size_t)ELM_ROWC(j + 1 + LA) * ZLD + ZC_AB);
            float acc[4], t[4];
#pragma unroll
            for (int e = 0; e < 4; ++e) acc[e] = 0.f;
#pragma unroll
            for (int k = 0; k < 3; ++k) { const u32x2 d = ELM_MSK(pw[j + k], j + k - 1, j); ELM_UNP4(d, t);
#pragma unroll
                for (int e = 0; e < 4; ++e) acc[e] += wa[k][e] * t[e]; }
            ELM_UNP4(abw[j], t);
            u32x2 o; o.x = cvt_pk_bf16(acc[0] * t[0], acc[1] * t[1]); o.y = cvt_pk_bf16(acc[2] * t[2], acc[3] * t[3]);
            *(u32x2*)(YC + (size_t)(r0 + j) * 1536 + ch) = o;
            __builtin_amdgcn_sched_barrier(0);
        }
    }
    {
        f32x4 wr[8], bs[2];
#pragma unroll
        for (int k = 0; k < 8; ++k) wr[k] = *(const f32x4*)(rcw + k * 512 + ch);
#pragma unroll
        for (int d = 0; d < 2; ++d) bs[d] = *(const f32x4*)(rcb + d * 512 + ch);
        u32x2 rxw[RL + 6];
#pragma unroll
        for (int i = 0; i < 7 + LA; ++i) rxw[i] = *(const u32x2*)(zb + (size_t)ELM_ROWC(i - 3) * ZLD + ZC_RX);
#pragma unroll
        for (int j = 0; j < RL; ++j) {
            if (j + 7 + LA < RL + 6) rxw[j + 7 + LA] = *(const u32x2*)(zb + (size_t)ELM_ROWC(j + 4 + LA) * ZLD + ZC_RX);
            float xf[4], xb[4], t[4];
#pragma unroll
            for (int e = 0; e < 4; ++e) { xf[e] = bs[0][e]; xb[e] = bs[1][e]; }
#pragma unroll
            for (int o = -3; o <= 3; ++o) { const u32x2 d = ELM_MSK(rxw[j + o + 3], j + o, j); ELM_UNP4(d, t);
                if (o <= 0) {
#pragma unroll
                    for (int e = 0; e < 4; ++e) xf[e] += wr[o + 3][e] * t[e]; }
                if (o >= 0) {
#pragma unroll
                    for (int e = 0; e < 4; ++e) xb[e] += wr[4 + o][e] * t[e]; } }
            u32x2 of, ob; of.x = cvt_pk_bf16(xf[0], xf[1]); of.y = cvt_pk_bf16(xf[2], xf[3]); ob.x = cvt_pk_bf16(xb[0], xb[1]); ob.y = cvt_pk_bf16(xb[2], xb[3]);
            *(u32x2*)(XC + (size_t)(r0 + j) * 1024 + ch) = of;
            *(u32x2*)(XC + (size_t)(r0 + j) * 1024 + 512 + ch) = ob;
            __builtin_amdgcn_sched_barrier(0);
        }
    }
#undef ELM_ROWC
#undef ELM_SID
#undef ELM_MSK
}
#undef ELM_UNP4
__device__ __forceinline__ void phase_elem(const Args& a, int l, bool probe = false) {
    const bf16_t* Z = (const bf16_t*)(a.ws + WS_Z); bf16_t* XC = (bf16_t*)(a.ws + WS_XC); bf16_t* YC = (bf16_t*)(a.ws + WS_YCAT);
    const float* caw = a.in[I_CONVA] + (size_t)l * 3 * 512; const float* rcw = a.in[I_RGCW] + (size_t)l * 2 * 4 * 512; const float* rcb = a.in[I_RGCB] + (size_t)l * 2 * 512;
    const int tid = otid(), wave = tid >> 6, lane = tid & 63;
    for (int item = blockIdx.x * 8 + wave; item < 2 * (CROWS / 9); item += gridDim.x * 8) {
        const int run = item >> 1, r0 = run * 9, ra = r0 - 3, rb = r0 + 9 + 2;
        const bool fast = ra >= 0 && rb < CROWS && (ra / TOK == rb / TOK) && ((ra % TOK < CTXL) == (rb % TOK < CTXL));
        int ch = (item & 1) * 256 + lane * 4; asm volatile("" : "+v"(ch));
        if (fast) elem_run<false>(Z, XC, YC, caw, rcw, rcb, r0, ch); else elem_run<true>(Z, XC, YC, caw, rcw, rcb, r0, ch);
    }
}

__device__ __forceinline__ void phase_scan(const Args& a, int l, LAS unsigned char* lds) {
    constexpr int SL = 36, NS = TOK / SL, CG = 8;
    LAS float* SG = (LAS float*)lds;
    LAS float* HL = (LAS float*)(lds + 8192);
    const int tid = otid(), chl = tid & 7, seg = tid >> 3;
    const bf16_t* Z = (const bf16_t*)(a.ws + WS_Z); const bf16_t* Gp = (const bf16_t*)(a.ws + WS_G);
    bf16_t* YC = (bf16_t*)(a.ws + WS_YCAT); const bf16_t* RGP = (const bf16_t*)(a.ws + WS_HF);
    const int G_ = gridDim.x, bx_ = blockIdx.x, vcu_ = (G_ % 8 == 0) ? (bx_ % 8) * (G_ / 8) + bx_ / 8 : bx_;
    for (int item = vcu_; item < CH * 64; item += G_) {
        const int s = item >> 6, ch = (item & 63) * CG + chl, rowbase = s * TOK;
        for (int dir = 0; dir < 2; ++dir) {
            const int q0 = seg * SL;
            const unsigned* gp = (const unsigned*)Gp + (size_t)(dir * 64 + (item & 63)) * CROWS * 8 + chl;
            unsigned pk[SL];
#pragma unroll
            for (int j = 0; j < SL; ++j) { int q = q0 + j; asm volatile("" : "+v"(q));
                const int row = rowbase + (dir == 0 ? q : (q < CTXL ? CTXL - 1 - q : TOK + CTXL - 1 - q));
                pk[j] = gp[(size_t)row * 8]; }
            float A = 1.f, Bv = 0.f, af[SL];
#pragma unroll
            for (int j = 0; j < SL; ++j) { const float aa = __builtin_amdgcn_exp2f(__uint_as_float(pk[j] << 16)); af[j] = aa; A *= aa; Bv = aa * Bv + __uint_as_float(pk[j] & 0xffff0000u); }
            SG[(seg * 2) * CG + chl] = A; SG[(seg * 2 + 1) * CG + chl] = Bv;
            __syncthreads();
            float h = 0.f;
            { int w2 = 0;
              for (; w2 + 8 <= seg; w2 += 8) { float ca_[8], cb_[8];
#pragma unroll
                  for (int k = 0; k < 8; ++k) { ca_[k] = SG[((w2 + k) * 2) * CG + chl]; cb_[k] = SG[((w2 + k) * 2 + 1) * CG + chl]; }
#pragma unroll
                  for (int k = 0; k < 8; ++k) h = ca_[k] * h + cb_[k]; }
              for (; w2 < seg; ++w2) h = SG[(w2 * 2) * CG + chl] * h + SG[(w2 * 2 + 1) * CG + chl]; }
            if (dir == 0) {
#pragma unroll
                for (int j = 0; j < SL; ++j) { int q = q0 + j; asm volatile("" : "+v"(q));
                    h = af[j] * h + __uint_as_float(pk[j] & 0xffff0000u); HL[(seg * 37 + j) * CG + chl] = h; }
            } else {
#pragma unroll
                for (int g0 = 0; g0 < SL; g0 += 12) {
                    float rg[12];
#pragma unroll
                    for (int j = 0; j < 12; ++j) { int q = q0 + g0 + j; asm volatile("" : "+v"(q)); const int row = rowbase + (q < CTXL ? CTXL - 1 - q : TOK + CTXL - 1 - q);
                        rg[j] = bf2f(RGP[((size_t)(item & 63) * CROWS + row) * 8 + chl]); }
#pragma unroll
                    for (int j = 0; j < 12; ++j) { int q = q0 + g0 + j; asm volatile("" : "+v"(q)); const int rl = (q < CTXL ? CTXL - 1 - q : TOK + CTXL - 1 - q), sr = rl / SL;
                        h = af[g0 + j] * h + __uint_as_float(pk[g0 + j] & 0xffff0000u);
                        const float hf = HL[(sr * 37 + (rl - sr * SL)) * CG + chl];
                        YC[(size_t)(rowbase + rl) * 1536 + 512 + ch] = f2bf(rg[j] * (hf + h)); }
                }
            }
            __syncthreads();
        }
    }
}

__device__ __forceinline__ void phase_attn(const Args& a, int l, unsigned char* ldsg) {
    const bf16_t* Z = (const bf16_t*)(a.ws + WS_Z); bf16_t* YC = (bf16_t*)(a.ws + WS_YCAT);
    const float lam = ((const float*)(a.ws + WS_LAM))[l];
    const float lam_init = 0.8f - 0.6f * expf(-0.3f * (float)l);
    const float* subw = a.in[I_SUBLN] + l * 128;
    const int G = gridDim.x, bx = blockIdx.x, vcu = (G % 8 == 0) ? (bx % 8) * (G / 8) + bx / 8 : bx;
    const int nitems = CH * 4 * 8 + (l == 0 ? CH * 4 : 0);
    bf16x8 pre_v0 = {0, 0, 0, 0, 0, 0, 0, 0}, pre_v1 = pre_v0, pre_k0 = pre_v0;
    for (int it = 0;; ++it) {
        int item = vcu + (it >> 1) * G; const int map = it & 1;
        if (G == 256 && (it >> 1) == 1) {
            const int k = bx - 64; item = (k >= 0 && k % 6 == 0 && k / 6 < CH * 4) ? CH * 32 + k / 6 : nitems; }
        if (item >= nitems) break;
        int s, h, qrow0, seq;
        if (item < CH * 32) { s = item >> 5; h = (item >> 3) & 3; qrow0 = s * TOK + CTXL + (item & 7) * 256; seq = TOK; }
        else { const int j = item - CH * 32; s = j >> 2; h = j & 3; qrow0 = s * TOK; seq = CTXL; }
        const bf16_t* zk = Z + (size_t)(s * TOK) * ZLD;
        f32x16 o[4];
        __syncthreads();
        att::attn_map(Z + (size_t)qrow0 * ZLD + ZC_Q + h * 128 + map * 64, zk + ZC_K + h * 128 + map * 64, zk + ZC_V + h * 128, seq, (char*)ldsg, o,
                      zk + ZC_K + h * 128 + 64, zk + ZC_V + h * 128, pre_v0, pre_v1, pre_k0, map == 1);
        int tz = threadIdx.x; asm volatile("" : "+v"(tz));
        const int wid = tz >> 6, lane = tz & 63, r32 = lane & 31, hi = lane >> 5;
        LAS unsigned* scr = (LAS unsigned*)((LAS unsigned char*)ldsg + 65536) + wid * 2048;
        if (map == 0) {
#pragma unroll
            for (int d = 0; d < 4; ++d)
#pragma unroll
                for (int r = 0; r < 16; r += 2) scr[(d * 8 + (r >> 1)) * 64 + lane] = cvt_pk_bf16(o[d][r], o[d][r + 1]);
        } else {
            float ssq[16];
#pragma unroll
            for (int r = 0; r < 16; ++r) ssq[r] = 0.f;
#pragma unroll
            for (int d = 0; d < 4; ++d)
#pragma unroll
                for (int r = 0; r < 16; ++r) { const unsigned pw = scr[(d * 8 + (r >> 1)) * 64 + lane]; const float o1 = (r & 1) ? __uint_as_float(pw & 0xffff0000u) : __uint_as_float(pw << 16);
                    const float v = o1 - lam * o[d][r]; o[d][r] = v; ssq[r] += v * v; }
#pragma unroll
            for (int r = 0; r < 16; ++r) {
#pragma unroll
                for (int x = 1; x < 32; x <<= 1) ssq[r] += __shfl_xor(ssq[r], x);
                ssq[r] = (1.0f - lam_init) / sqrtf(ssq[r] * (1.0f / 128.0f) + EPS); }
#pragma unroll
            for (int d = 0; d < 4; ++d) { const float wv = subw[d * 32 + r32];
#pragma unroll
                for (int r = 0; r < 16; ++r) YC[(size_t)(qrow0 + wid * 32 + att::crow(r, hi)) * 1536 + 1024 + h * 128 + d * 32 + r32] = f2bf(o[d][r] * ssq[r] * wv); }
        }
    }
}

__device__ __forceinline__ void copy_ctx_side(const Args& a, int c) {
    const int tid = otid(), wave = tid >> 6, lane = tid & 63;
    const bf16_t* YC = (const bf16_t*)(a.ws + WS_YCAT);
    bf16_t* YCC = (bf16_t*)(a.ws + WS_YCATC); bf16_t* ZGC = (bf16_t*)(a.ws + WS_ZGC);
    for (int i = blockIdx.x * 8 + wave; i < CH * CTXL; i += gridDim.x * 8) {
        const int s = i >> 8, w = i & 255; const size_t row = (size_t)s * TOK + w, grow = (size_t)(c * CH + s) * CTXL + w;
        const u32x4* ys = (const u32x4*)(YC + row * 1536); u32x4* yd = (u32x4*)(YCC + grow * 1536);
#pragma unroll
        for (int q = 0; q < 3; ++q) yd[q * 64 + lane] = ys[q * 64 + lane];
    }
    const u32x4* gt = (const u32x4*)(a.ws + WS_GZT);
    for (int i = blockIdx.x * NTHREADS + tid; i < CH * 12 * 4096; i += gridDim.x * NTHREADS) {
        const int s = i / (12 * 4096), o = i - s * (12 * 4096);
        ((u32x4*)ZGC)[(size_t)(c * CH + s) * (12 * 4096) + o] = gt[(size_t)(9 * s) * (12 * 4096) + o];
    }
}

__device__ __forceinline__ void moe_pad_end(const int* cnt, int (&pe)[8]) {
    int acc = 0;
#pragma unroll
    for (int e = 0; e < 8; ++e) { const int n = __builtin_amdgcn_readfirstlane(__hip_atomic_load(cnt + e, __ATOMIC_RELAXED, __HIP_MEMORY_SCOPE_AGENT)); acc += (n + 255) & ~255; pe[e] = acc; }
}
__device__ __forceinline__ void phase_scatter(const Args& a, int c) {
    const int tid = otid(), wave = tid >> 6, lane = tid & 63;
    int* cnt = (int*)(a.ws + WS_CTL + CTL_CNT) + c * 32;
    int pe[8]; moe_pad_end(cnt, pe);
    const int* te = (const int*)(a.ws + WS_TOKE); const int* ts = (const int*)(a.ws + WS_TOKS); int* tsl = (int*)(a.ws + WS_TSLOT);
    const bf16_t* U = (const bf16_t*)(a.ws + WS_U); bf16_t* HS = (bf16_t*)(a.ws + WS_HS);
    const int per = (2 * MTOK + (int)gridDim.x * 8 - 1) / ((int)gridDim.x * 8), i0 = ((int)blockIdx.x * 8 + wave) * per, i1 = (i0 + per < 2 * MTOK) ? i0 + per : 2 * MTOK;
    for (int base = i0; base < i1; base += 16) {
        const int il = base + (lane & 15), ic = (il < i1) ? il : i1 - 1;
        const int e = te[ic], pos = ts[ic];
        int ps = 0;
#pragma unroll
        for (int j = 0; j < 7; ++j) ps = (e > j) ? pe[j] : ps;
        const int slot = ps + pos;
        if (lane < 16 && il < i1) tsl[il] = slot;
        u32x4 buf[16];
#pragma unroll
        for (int k = 0; k < 16; ++k) { const int i = (base + k < i1) ? base + k : i1 - 1, t = i >> 1, row = (t >> 11) * TOK + CTXL + (t & 2047);
            buf[k] = ((const u32x4*)((const unsigned char*)U + (size_t)row * D))[lane]; }
#pragma unroll
        for (int k = 0; k < 16; ++k) { const int sk = __builtin_amdgcn_readlane(slot, k);
            if (base + k < i1) ((u32x4*)((unsigned char*)HS + (size_t)sk * D))[lane] = buf[k]; }
    }
}
__device__ __forceinline__ f32x4 ld4bf(const bf16_t* p) { const u32x2 pk = *(const u32x2*)p; return (f32x4){__uint_as_float(pk.x << 16), __uint_as_float(pk.x & 0xffff0000u), __uint_as_float(pk.y << 16), __uint_as_float(pk.y & 0xffff0000u)}; }
__device__ __forceinline__ void phase_combine(const Args& a, int c, bool probe = false) {
    const int tid = otid(), wave = tid >> 6, lane = tid & 63;
    const bf16_t* YS = (const bf16_t*)(a.ws + WS_YS); const int* ts = (const int*)(a.ws + WS_TSLOT); const float* tp = (const float*)(a.ws + WS_TOKP);
    const bf16_t* XB = (const bf16_t*)(a.ws + WS_XB);
    const float* MOD = (const float*)(a.ws + WS_MOD) + (size_t)33 * 6144;
    const float* fw = a.in[I_FNW];
    const int per = (MTOK + (int)gridDim.x * 8 - 1) / ((int)gridDim.x * 8), tb = ((int)blockIdx.x * 8 + wave) * per, te = (tb + per < MTOK) ? tb + per : MTOK;
    if (tb >= te) return;
    f32x4 fwv[4], gv[4];
#pragma unroll
    for (int i = 0; i < 4; ++i) { fwv[i] = *(const f32x4*)(fw + lane * 4 + 256 * i); gv[i] = (f32x4){0.f, 0.f, 0.f, 0.f}; }
    int bcur = -1;
    u32x2 xc[4], y0c[4], y1c[4], xn[4], y0n[4], y1n[4];
    int s0c, s1c, s0n, s1n; float p0c, p1c, p0n, p1n;
#define CMB_IDX(T, S0, S1, P0, P1) do { S0 = ts[2 * (T)]; S1 = ts[2 * (T) + 1]; P0 = tp[2 * (T)]; P1 = tp[2 * (T) + 1]; } while (0)
#define CMB_ROWS(T, S0, S1, X, Y0, Y1) do { const bf16_t* xb_ = XB + ((size_t)(c * CH + ((T) >> 11)) * SEQ + ((T) & 2047)) * D + lane * 4; \
        const bf16_t* q0_ = YS + (size_t)(S0) * D + lane * 4; const bf16_t* q1_ = YS + (size_t)(S1) * D + lane * 4; \
        _Pragma("unroll") for (int i = 0; i < 4; ++i) { X[i] = *(const u32x2*)(xb_ + 256 * i); Y0[i] = *(const u32x2*)(q0_ + 256 * i); Y1[i] = *(const u32x2*)(q1_ + 256 * i); } } while (0)
#define CMB_F4(P) ((f32x4){__uint_as_float((P).x << 16), __uint_as_float((P).x & 0xffff0000u), __uint_as_float((P).y << 16), __uint_as_float((P).y & 0xffff0000u)})
    CMB_IDX(tb, s0c, s1c, p0c, p1c);
    CMB_ROWS(tb, s0c, s1c, xc, y0c, y1c);
    { const int tn = (tb + 1 < te) ? tb + 1 : te - 1; CMB_IDX(tn, s0n, s1n, p0n, p1n); }
    for (int t = tb; t < te; ++t) {
        const int tn = (t + 1 < te) ? t + 1 : te - 1, tn2 = (t + 2 < te) ? t + 2 : te - 1;
        CMB_ROWS(tn, s0n, s1n, xn, y0n, y1n);
        int s0f, s1f; float p0f, p1f; CMB_IDX(tn2, s0f, s1f, p0f, p1f);
        const int b = c * CH + (t >> 11); float* xr = a.out + ((size_t)b * SEQ + (t & 2047)) * D;
        if (b != bcur) { const float* g2 = MOD + (size_t)b * 6144 + 5120;
#pragma unroll
            for (int i = 0; i < 4; ++i) gv[i] = *(const f32x4*)(g2 + lane * 4 + 256 * i);
            bcur = b; }
        f32x4 v[4]; float ss = 0.f;
        if (s0c < 32768 && s1c < 32768) {
#pragma unroll
            for (int i = 0; i < 4; ++i) { v[i] = CMB_F4(xc[i]) + gv[i] * (CMB_F4(y0c[i]) * p0c + CMB_F4(y1c[i]) * p1c);
                ss += v[i][0] * v[i][0] + v[i][1] * v[i][1] + v[i][2] * v[i][2] + v[i][3] * v[i][3]; }
        } else {
            const bf16_t* PB = (const bf16_t*)(a.ws + WS_OSCR);
            const bool o0 = s0c >= 32768, o1 = s1c >= 32768;
            const bf16_t* q0 = o0 ? PB + (size_t)(s0c - 32768) * D : YS + (size_t)s0c * D; const bf16_t* q1 = o1 ? PB + (size_t)(s1c - 32768) * D : YS + (size_t)s1c * D;
            const size_t st0 = o0 ? (size_t)2048 * D : 0, st1 = o1 ? (size_t)2048 * D : 0; const float w0 = o0 ? 1.f : 0.f, w1 = o1 ? 1.f : 0.f;
#pragma unroll
            for (int i = 0; i < 4; ++i) { const int col = lane * 4 + 256 * i;
                const f32x4 y0 = ld4bf(q0 + col) + ld4bf(q0 + st0 + col) * w0;
                const f32x4 y1 = ld4bf(q1 + col) + ld4bf(q1 + st1 + col) * w1;
                v[i] = CMB_F4(xc[i]) + gv[i] * (y0 * p0c + y1 * p1c);
                ss += v[i][0] * v[i][0] + v[i][1] * v[i][1] + v[i][2] * v[i][2] + v[i][3] * v[i][3]; }
        }
        ss = wave_sum(ss);
        const float rstd = 1.0f / sqrtf(ss * (1.0f / 1024.0f) + EPS);
        float* dst = probe ? (float*)(a.ws + WS_HF) + (size_t)(t & 8191) * D : xr;
#pragma unroll
        for (int i = 0; i < 4; ++i) { const int col = lane * 4 + 256 * i; *(f32x4*)(dst + col) = v[i] * rstd * fwv[i]; }
#pragma unroll
        for (int i = 0; i < 4; ++i) { xc[i] = xn[i]; y0c[i] = y0n[i]; y1c[i] = y1n[i]; }
        s0c = s0n; s1c = s1n; p0c = p0n; p1c = p1n; s0n = s0f; s1n = s1f; p0n = p0f; p1n = p1f;
    }
#undef CMB_IDX
#undef CMB_ROWS
#undef CMB_F4
}

#ifndef SITE_MASK
#define SITE_MASK 0xFFFFFFFFu
#endif
constexpr int STEPS_L0 = 8, STEPS_L1 = 10, NSTEPS = 1 + 2 + NCH * (STEPS_L0 + STEPS_L1) + 4;

__global__ void __launch_bounds__(NTHREADS, 2) hybrid_fwd(Args a) {
    extern __shared__ __attribute__((aligned(16))) unsigned char lds[];
    LAS unsigned char* ldsl = (LAS unsigned char*)lds;
    const int lo = a.ph_lo, hi = a.ph_hi;
    if (threadIdx.x < 16) ((LAS unsigned*)(ldsl + MISC_OFF))[threadIdx.x] = 0u;
    __syncthreads();
    XcdBarrier bar; bar.bar = (unsigned*)(a.ws + WS_CTL); bar.x = 0; bar.st = (volatile LAS unsigned*)(ldsl + MISC_OFF);
    if (hi - lo > 1) bar = xcd_barrier_post((unsigned*)(a.ws + WS_CTL), (volatile LAS unsigned*)(ldsl + MISC_OFF));
    int step = 0;
#define RUN(site, ...) do { if (step >= lo && step < hi) { if constexpr ((SITE_MASK >> (site)) & 1) { for (int rep_ = 0; rep_ < (((site) == REP_SITE) ? REP_N + 1 : 1); ++rep_) { __VA_ARGS__; } } if (step + 1 < hi) { for (int rb_ = 0; rb_ < BAR_N; ++rb_) xcd_barrier(bar); } } ++step; } while (0)
    const int G = gridDim.x, bx = blockIdx.x;
    unsigned char* ws = a.ws;

    RUN(0, phase_prologue(a, ldsl));

    for (int l = 0; l < 2; ++l) {
        for (int c = 0; c < NCH; ++c) {
            const int latonly = 1;
            const int nMres = CH * 8;
            if (c == 0) RUN(1, phase_norm<false>(a, l, c, 0, false, ldsl));
            RUN(2, { pg8::SchedPlain S{(const char*)(ws + WS_U), (const char*)(ws + WS_WIN) + (size_t)l * DIN * D * 2, (size_t)256 * D * 2, (size_t)256 * D * 2, CTILES, DIN / 256, G, bx, (l == 1) ? 2 : 0};
                  pg8::EpiBf16 E{(bf16_t*)(ws + WS_Z), ZLD, nullptr, ZC_GA / 256, (bf16_t*)(ws + WS_GZT), (const float*)(ws + WS_ROPE), ZC_Q / 256, ZC_V / 256, ZC_AC / 256, ZC_RG / 256, ZC_RG / 256, ZC_RX / 256, (bf16_t*)(ws + WS_HF)};
                  pg8::gemm_phase<false>(ldsl, (D) * 2, (D) * 2, (D) / 64, S, E); });
            RUN(3, phase_elem(a, l, rep_ != 0));
            RUN(4, { pg8::SchedGate S{(const char*)(ws + WS_XC), (const char*)(ws + WS_WG) + (size_t)l * 8 * 256 * 256 * 2, G, bx, (l == 0 && G == 256) ? 1 : 0};
                  pg8::EpiGate E{(bf16_t*)(ws + WS_G), (const bf16_t*)(ws + WS_XC), (const float*)(ws + WS_GB) + l * 2048, (const float*)(ws + WS_COEF) + l * 1024};
                  pg8::gemm_phase<false>(ldsl, (1024) * 2, (256) * 2, (256) / 64, S, E);
                  __syncthreads(); phase_attn(a, l, lds); });
            RUN(5, phase_scan(a, l, ldsl));
            RUN(7, { pg8::SchedMerge S{(const char*)(ws + WS_YCAT), (const char*)(ws + WS_WBR) + (size_t)l * D * 1536 * 2, nMres, G, bx, latonly};
                  pg8::EpiMerge E{(const bf16_t*)(ws + WS_GZT), (bf16_t*)(ws + WS_M)};
                  pg8::gemm_phase<false>(ldsl, (1536) * 2, (1536) * 2, (512) / 64, S, E);
                  if (l == 0) copy_ctx_side(a, c); });
            RUN(8, { pg8::SchedPlain S{(const char*)(ws + WS_M), (const char*)(ws + WS_WOUT) + (size_t)l * D * D * 2, (size_t)256 * D * 2, (size_t)256 * D * 2, nMres, 4, G, bx, latonly};
                  const float* gp = rep_ == 0 ? (const float*)(ws + WS_MOD) + (size_t)l * 33 * 6144 + 2048 : (const float*)(ws + WS_CTL + CTL_ZEROG);
                  if (l == 0 && rep_ == 0 && G == 256) {
                      pg8::EpiResNorm E{a.in[I_X], (bf16_t*)(ws + WS_XB), gp, (const float*)(ws + WS_MOD) + 3072, a.in[I_N2W], ws + WS_U, (float*)(ws + WS_OSCR + (size_t)16 * 1024 * 1024),
                                        (unsigned*)(ws + WS_CTL + CTL_PANEL), (unsigned*)(ws + WS_CTL) + XB_TMO, 32u * (unsigned)(c + 1), c, ldsl + 131072, 0};
                      pg8::gemm_phase<false>(ldsl, (D) * 2, (D) * 2, (D) / 64, S, E); }
                  else if (l == 0 && rep_ == 0) { pg8::EpiRes<true> E{(const void*)a.in[I_X], (const void*)a.in[I_CTX], (bf16_t*)(ws + WS_XB), (bf16_t*)(ws + WS_CX), gp, c, 0};
                      pg8::gemm_phase<false>(ldsl, (D) * 2, (D) * 2, (D) / 64, S, E); }
                  else if (l == 1 && rep_ == 0 && G == 256) {
                      pg8::EpiResRouter E{(const bf16_t*)(ws + WS_XB), (bf16_t*)(ws + WS_XB), gp, (const float*)(ws + WS_MOD) + (size_t)33 * 6144 + 3072, a.in[I_N2W] + D, a.in[I_ROUTER], ws + WS_U,
                                          (float*)(ws + WS_OSCR + (size_t)16 * 1024 * 1024), (unsigned*)(ws + WS_CTL + CTL_PANEL), (unsigned*)(ws + WS_CTL) + XB_TMO, 32u * (unsigned)(NCH + c + 1), c,
                                          (int*)(ws + WS_TOKE), (float*)(ws + WS_TOKP), (int*)(ws + WS_TOKS), (int*)(ws + WS_CTL + CTL_CNT) + c * 32, ldsl};
                      pg8::gemm_phase<false>(ldsl, (D) * 2, (D) * 2, (D) / 64, S, E); }
                  else { pg8::EpiRes<false> E{(const void*)(ws + WS_XB), (const void*)(ws + WS_CX), (bf16_t*)(ws + WS_XB), (bf16_t*)(ws + WS_CX), gp, c, 0};
                      pg8::gemm_phase<false>(ldsl, (D) * 2, (D) * 2, (D) / 64, S, E); } });
            if (l == 0) {
                if (G != 256) { phase_norm<false>(a, l, c, 1, true, ldsl); xcd_barrier(bar); }
                RUN(10, { constexpr int EB = DENSE_F8 ? 1 : 2;
                      pg8::SchedPlain S{(const char*)(ws + WS_U), (const char*)(ws + WS_F13), (size_t)256 * D * EB, (size_t)256 * D * EB, CH * 8, DIN / 256, G, bx, 1};
                      pg8::EpiSwiglu<DENSE_F8> E{(bf16_t*)(ws + WS_ACT)};
                      pg8::gemm_phase<DENSE_F8>(ldsl, D * EB, D * EB, D * EB / 128, S, E); });
                RUN(11, { constexpr int EB = DENSE_F8 ? 1 : 2;
                      pg8::SchedPlain S{(const char*)(ws + WS_ACT), (const char*)(ws + WS_F2), (size_t)256 * FF * EB, (size_t)256 * FF * EB, CH * 8, 4, G, bx, 1};
                      pg8::EpiRes<false> E{(const void*)(ws + WS_XB), (const void*)(ws + WS_CX), (bf16_t*)(ws + WS_XB), (bf16_t*)(ws + WS_CX), rep_ == 0 ? (const float*)(ws + WS_MOD) + (size_t)l * 33 * 6144 + 5120 : (const float*)(ws + WS_CTL + CTL_ZEROG), c, 0};
                      pg8::gemm_phase<DENSE_F8>(ldsl, FF * EB, FF * EB, FF * EB / 128, S, E);
                      if (c + 1 < NCH) { __syncthreads(); phase_norm<false>(a, l, c + 1, 0, false, ldsl); } });
            } else {
                if (G != 256) { phase_norm<true>(a, l, c, 1, true, ldsl, false); xcd_barrier(bar); }
                RUN(13, phase_scatter(a, c));
                RUN(14, { pg8::SchedMoe S; S.A = (const char*)(ws + WS_HS); S.B = (const char*)(ws + WS_M13); S.a_ts = (size_t)256 * D; S.b_ts = (size_t)256 * D; S.e_stride = (size_t)DIN * D;
                      S.nN = DIN / 256; S.G = G; S.c = bx; moe_pad_end((const int*)(ws + WS_CTL + CTL_CNT) + c * 32, S.pe); S.nM = S.pe[7] >> 8;
                      pg8::EpiSwiglu<true> E{(bf16_t*)(ws + WS_ACT)};
                      pg8::gemm_phase<true>(ldsl, D, D, D / 128, S, E); });
                RUN(15, { pg8::SchedMoe S; S.A = (const char*)(ws + WS_ACT); S.B = (const char*)(ws + WS_M2); S.a_ts = (size_t)256 * FF; S.b_ts = (size_t)256 * FF; S.e_stride = (size_t)D * FF;
                      S.nN = 4; S.G = G; S.c = bx; moe_pad_end((const int*)(ws + WS_CTL + CTL_CNT) + c * 32, S.pe); const int nMt = S.pe[7] >> 8; S.nM = nMt < 128 ? nMt : 128;
                      pg8::EpiBf16 E{(bf16_t*)(ws + WS_YS), D, nullptr, 1 << 30, nullptr, nullptr, 1 << 30, 1 << 30, 1 << 30, 1 << 30, 1 << 30, 1 << 30};
                      pg8::gemm_phase<true>(ldsl, FF, FF, FF / 128, S, E);
                      if (nMt > 128) {
                          __syncthreads();
                          pg8::SchedMoeSplit S2; S2.A = S.A; S2.B = S.B; S2.a_ts = S.a_ts; S2.b_ts = S.b_ts; S2.e_stride = S.e_stride; S2.nR = nMt - 128; S2.G = G; S2.c = bx;
                          _Pragma("unroll") for (int j = 0; j < 8; ++j) S2.pe[j] = S.pe[j];
                          pg8::EpiBf16 E2{(bf16_t*)(ws + WS_OSCR), D, nullptr, 1 << 30, nullptr, nullptr, 1 << 30, 1 << 30, 1 << 30, 1 << 30, 1 << 30, 1 << 30};
                          pg8::gemm_phase<true>(ldsl, FF, FF, 14, S2, E2); } });
                RUN(16, { phase_combine(a, c, rep_ != 0); if (c + 1 < NCH) phase_norm<false>(a, l, c + 1, 0, false, ldsl); });
            }
        }
        if (l == 0) {
            RUN(17, { pg8::SchedMerge S{(const char*)(ws + WS_YCATC), (const char*)(ws + WS_WBR), NB, G, bx, 0};
                      pg8::EpiMerge E{(const bf16_t*)(ws + WS_ZGC), (bf16_t*)(ws + WS_M)};
                      pg8::gemm_phase<false>(ldsl, (1536) * 2, (1536) * 2, (512) / 64, S, E); });
            RUN(18, { pg8::SchedPlain S{(const char*)(ws + WS_M), (const char*)(ws + WS_WOUT), (size_t)256 * D * 2, (size_t)256 * D * 2, NB, 4, G, bx, 0};
                      if (G == 256) {
                          pg8::EpiResNorm E{a.in[I_CTX], (bf16_t*)(ws + WS_CX), (const float*)(ws + WS_MOD) + 2048, (const float*)(ws + WS_MOD) + 3072, a.in[I_N2W], ws + WS_U, (float*)(ws + WS_OSCR + (size_t)16 * 1024 * 1024),
                                            (unsigned*)(ws + WS_CTL + CTL_PANEL) + 64 * 72, (unsigned*)(ws + WS_CTL) + XB_TMO, 32u, 0, ldsl + 131072, 1};
                          pg8::gemm_phase<false>(ldsl, (D) * 2, (D) * 2, (D) / 64, S, E); }
                      else { pg8::EpiRes<true> E{(const void*)a.in[I_X], (const void*)a.in[I_CTX], (bf16_t*)(ws + WS_XB), (bf16_t*)(ws + WS_CX), (const float*)(ws + WS_MOD) + 2048, 0, 1};
                          pg8::gemm_phase<false>(ldsl, (D) * 2, (D) * 2, (D) / 64, S, E); } });
            if (G != 256) { phase_norm<false>(a, 0, 0, 1, false, ldsl, false, true); xcd_barrier(bar); }
            RUN(20, { constexpr int EB = DENSE_F8 ? 1 : 2;
                      pg8::SchedPlain S{(const char*)(ws + WS_U), (const char*)(ws + WS_F13), (size_t)256 * D * EB, (size_t)256 * D * EB, NB, DIN / 256, G, bx, 0};
                      pg8::EpiSwiglu<DENSE_F8> E{(bf16_t*)(ws + WS_ACT)};
                      pg8::gemm_phase<DENSE_F8>(ldsl, D * EB, D * EB, D * EB / 128, S, E); });
            RUN(21, { constexpr int EB = DENSE_F8 ? 1 : 2;
                      pg8::SchedPlain S{(const char*)(ws + WS_ACT), (const char*)(ws + WS_F2), (size_t)256 * FF * EB, (size_t)256 * FF * EB, NB, 4, G, bx, 0};
                      pg8::EpiRes<false> E{(const void*)(ws + WS_XB), (const void*)(ws + WS_CX), (bf16_t*)(ws + WS_XB), (bf16_t*)(ws + WS_CX), (const float*)(ws + WS_MOD) + 5120, 0, 1};
                      pg8::gemm_phase<DENSE_F8>(ldsl, FF * EB, FF * EB, FF * EB / 128, S, E); });
        }
    }
#undef RUN
}

#ifndef MK_N_LAUNCHES
#define MK_N_LAUNCHES 1
#endif
extern "C" void kernel_launch(void* const* d_in, const int* in_sizes, int n_in, void* d_out, int out_size, void* d_ws, size_t ws_size, hipStream_t stream) {
    static int grid = 0;
    if (grid == 0) {
        if (n_in != 27 || out_size != NB * SEQ * D || ws_size < WS_END) { fprintf(stderr, "kernel_launch: unexpected shapes: n_in %d out %d ws %zu (need %zu)\n", n_in, out_size, ws_size, (size_t)WS_END); grid = -1; return; }
        int dev = 0, cus = 0, per_cu = 0;
        if (hipGetDevice(&dev) != hipSuccess || hipDeviceGetAttribute(&cus, hipDeviceAttributeMultiprocessorCount, dev) != hipSuccess) { grid = -1; return; }
        if (hipFuncSetAttribute((const void*)hybrid_fwd, hipFuncAttributeMaxDynamicSharedMemorySize, LDS_BYTES) != hipSuccess) { fprintf(stderr, "kernel_launch: hipFuncSetAttribute failed\n"); grid = -1; return; }
        if (hipOccupancyMaxActiveBlocksPerMultiprocessor(&per_cu, (const void*)hybrid_fwd, NTHREADS, LDS_BYTES) != hipSuccess || per_cu < 1) { fprintf(stderr, "kernel_launch: occupancy query says %d\n", per_cu); }
        (void)hipGetLastError();
        grid = cus;
    }
    if (grid < 0) return;
    if (hipMemsetAsync((char*)d_ws + WS_CTL, 0, CTL_BYTES, stream) != hipSuccess) return;
    Args a{};
    for (int i = 0; i < 27; ++i) a.in[i] = (const float*)d_in[i];
    a.out = (float*)d_out; a.ws = (unsigned char*)d_ws;
#if MK_N_LAUNCHES == 1
    a.ph_lo = 0; a.ph_hi = NSTEPS;
    hipLaunchKernelGGL(hybrid_fwd, dim3(grid), dim3(NTHREADS), LDS_BYTES, stream, a);
#else
    for (int s = 0; s < NSTEPS; ++s) { a.ph_lo = s; a.ph_hi = s + 1; hipLaunchKernelGGL(hybrid_fwd, dim3(grid), dim3(NTHREADS), LDS_BYTES, stream, a); }
#endif
}
```
